# Optimizing an MI355X kernel written in HIP

```python
import math
import jax, jax.numpy as jnp
from jax import lax
import numpy as np

D_MODEL = 1024
BATCH = 4
SEQ = 8192
DEPTH = 2

GRID_W = 64
Q_BLOCK = 128
RET_CHUNK = 128
NORM_EPS = 1e-6

DIFF_HEADS = 4
DIFF_HEAD_DIM = 64
DIFF_V_DIM = 2 * DIFF_HEAD_DIM
DIFF_WIDTH = DIFF_HEADS * DIFF_V_DIM
PARTIAL_ROT_DIM = DIFF_HEAD_DIM // 4
PARTIAL_ROPE_THETA = 500000.0

RET_HEADS = 4
RET_KEY_DIM = 128
RET_VAL_DIM = 128
RET_WIDTH = RET_HEADS * RET_VAL_DIM
RET_ROPE_THETA = 10000.0

GQA_Q_HEADS = 8
GQA_KV_HEADS = 2
GQA_GROUP = GQA_Q_HEADS // GQA_KV_HEADS
GQA_HEAD_DIM = 64
GQA_WIDTH = GQA_Q_HEADS * GQA_HEAD_DIM
AXIAL_DIM = GQA_HEAD_DIM // 2
AXIAL_ROPE_THETA = 10000.0

N_BRANCHES = 3
BRANCH_WIDTH = 512
D_FF = 4 * D_MODEL

IN_SPLITS = (
    DIFF_HEADS * 2 * DIFF_HEAD_DIM,
    DIFF_HEADS * 2 * DIFF_HEAD_DIM,
    DIFF_WIDTH,
    RET_HEADS * RET_KEY_DIM,
    RET_HEADS * RET_KEY_DIM,
    RET_WIDTH,
    RET_WIDTH,
    GQA_Q_HEADS * GQA_HEAD_DIM,
    GQA_KV_HEADS * GQA_HEAD_DIM,
    GQA_KV_HEADS * GQA_HEAD_DIM,
    N_BRANCHES * D_MODEL,
)
IN_COLS = 7424

kernel_name = "gated_parallel_diffattn_retention_axialgqa_encoder"


def rms_norm(x, gain, eps=NORM_EPS):
    xf = x.astype(jnp.float32)
    y = xf * lax.rsqrt(jnp.mean(xf * xf, axis=-1, keepdims=True) + eps)
    return (y * gain.astype(jnp.float32)).astype(x.dtype)


def rope_cos_sin(pos, dim, theta):
    inv_freq = theta ** (-jnp.arange(0, dim, 2, dtype=jnp.float32) / dim)
    ang = pos[:, None] * inv_freq[None, :]
    return jnp.cos(ang), jnp.sin(ang)


def apply_rope(x, cos_sin):
    cos, sin = cos_sin
    n = x.shape[-1] // 2
    shape = (1, cos.shape[0]) + (1,) * (x.ndim - 3) + (n,)
    c = cos.reshape(shape).astype(x.dtype)
    s = sin.reshape(shape).astype(x.dtype)
    x1, x2 = x[..., :n], x[..., n:]
    return jnp.concatenate([x1 * c - x2 * s, x2 * c + x1 * s], axis=-1)


def split_cols(y, sizes):
    out, start = [], 0
    for n in sizes:
        out.append(y[..., start:start + n])
        start += n
    return out


def sweep_query_blocks(fn, q):
    B, S = q.shape[:2]
    nb = S // Q_BLOCK
    qb = jnp.moveaxis(q.reshape((B, nb, Q_BLOCK) + q.shape[2:]), 1, 0)
    ob = lax.map(fn, qb)
    return jnp.moveaxis(ob, 0, 1).reshape((B, S) + ob.shape[3:])


def differential_attention(q, k, v, lam):
    scale = DIFF_HEAD_DIM ** -0.5

    def block(qb):
        s = jnp.einsum('bqhmd,bkhmd->bhmqk', qb, k).astype(jnp.float32) * scale
        p = jax.nn.softmax(s, axis=-1)
        w = (p[:, :, 0] - lam * p[:, :, 1]).astype(v.dtype)
        return jnp.einsum('bhqk,bkhe->bqhe', w, v)

    return sweep_query_blocks(block, q)


def grouped_query_attention(q, k, v):
    scale = GQA_HEAD_DIM ** -0.5

    def block(qb):
        s = jnp.einsum('bqgrd,bkgd->bgrqk', qb, k).astype(jnp.float32) * scale
        p = jax.nn.softmax(s, axis=-1).astype(v.dtype)
        return jnp.einsum('bgrqk,bkgd->bqgrd', p, v)

    return sweep_query_blocks(block, q)


def bidirectional_retention(q, k, v, log_fwd, log_bwd):
    B, S, H, dk = q.shape
    dv = v.shape[-1]
    C = RET_CHUNK
    N = S // C
    q = q.reshape(B, N, C, H, dk)
    k = k.reshape(B, N, C, H, dk)
    v = v.reshape(B, N, C, H, dv)
    i = jnp.arange(C, dtype=jnp.float32)
    diff = i[:, None] - i[None, :]
    decay_intra = jnp.where(
        diff[None] >= 0,
        jnp.exp(jnp.maximum(diff, 0.0)[None] * log_fwd[:, None, None]),
        jnp.exp(jnp.maximum(-diff, 0.0)[None] * log_bwd[:, None, None]))
    scores = jnp.einsum('bnihd,bnjhd->bnhij', q, k) * decay_intra
    out = jnp.einsum('bnhij,bnjhe->bnihe', scores, v)

    zeta_f = jnp.exp((C - 1 - i)[None] * log_fwd[:, None])
    xi_f = jnp.exp((i + 1)[None] * log_fwd[:, None])
    zeta_b = jnp.exp(i[None] * log_bwd[:, None])
    xi_b = jnp.exp((C - i)[None] * log_bwd[:, None])
    kv_f = jnp.einsum('bnjhd,bnjhe,hj->nbhde', k, v, zeta_f)
    kv_b = jnp.einsum('bnjhd,bnjhe,hj->nbhde', k, v, zeta_b)
    dec_f = jnp.exp(C * log_fwd)[None, :, None, None]
    dec_b = jnp.exp(C * log_bwd)[None, :, None, None]

    def chunk_states(kv, decay, reverse):
        def step(state, kv_n):
            return state * decay + kv_n, state
        _, states = lax.scan(step, jnp.zeros_like(kv[0]), kv, reverse=reverse)
        return states

    s_f = chunk_states(kv_f, dec_f, False)
    s_b = chunk_states(kv_b, dec_b, True)
    out = (out
           + jnp.einsum('bnihd,nbhde,hi->bnihe', q, s_f, xi_f)
           + jnp.einsum('bnihd,nbhde,hi->bnihe', q, s_b, xi_b))
    return out.reshape(B, S, H, dv)


def head_group_norm(x, gain, eps=1e-5):
    xf = x.astype(jnp.float32)
    mu = jnp.mean(xf, axis=-1, keepdims=True)
    var = jnp.mean(jnp.square(xf - mu), axis=-1, keepdims=True)
    y = ((xf - mu) * lax.rsqrt(var + eps)).reshape(x.shape[0], x.shape[1], -1)
    return y * gain.astype(jnp.float32)


def setup_inputs(seed: int = 0) -> dict:
    key = jax.random.key(seed)
    ks = jax.random.split(key, 21)
    L, D = DEPTH, D_MODEL
    f32 = jnp.float32

    def normal(k, shape, scale):
        return jax.random.normal(k, shape, f32) * scale

    def gain(k, shape):
        return 1.0 + 0.02 * jax.random.normal(k, shape, f32)

    base_log_decay = jnp.log(-jnp.log1p(-(2.0 ** (-5.0 - jnp.arange(RET_HEADS, dtype=f32)))))
    return {
        "x": jax.random.normal(ks[0], (BATCH, SEQ, D), f32),
        "attn_norm": gain(ks[1], (L, D)),
        "w_in": normal(ks[2], (L, D, IN_COLS), D ** -0.5),
        "diff_q_norm": gain(ks[3], (L, DIFF_HEAD_DIM)),
        "diff_k_norm": gain(ks[4], (L, DIFF_HEAD_DIM)),
        "diff_lam_q1": normal(ks[5], (L, DIFF_HEAD_DIM), 0.1),
        "diff_lam_k1": normal(ks[6], (L, DIFF_HEAD_DIM), 0.1),
        "diff_lam_q2": normal(ks[7], (L, DIFF_HEAD_DIM), 0.1),
        "diff_lam_k2": normal(ks[8], (L, DIFF_HEAD_DIM), 0.1),
        "diff_subln": gain(ks[9], (L, DIFF_V_DIM)),
        "ret_decay_fwd": base_log_decay[None] + normal(ks[10], (L, RET_HEADS), 0.1),
        "ret_decay_bwd": base_log_decay[None] + normal(ks[11], (L, RET_HEADS), 0.1),
        "ret_group_norm": gain(ks[12], (L, RET_WIDTH)),
        "gqa_q_norm": gain(ks[13], (L, GQA_HEAD_DIM)),
        "gqa_k_norm": gain(ks[14], (L, GQA_HEAD_DIM)),
        "w_branch": normal(ks[15], (L, N_BRANCHES, BRANCH_WIDTH, D), BRANCH_WIDTH ** -0.5),
        "w_out": normal(ks[16], (L, D, D), D ** -0.5),
        "mlp_norm": gain(ks[17], (L, D)),
        "w_mlp_in": normal(ks[18], (L, D, D_FF), D ** -0.5),
        "w_mlp_out": normal(ks[19], (L, D_FF, D), D_FF ** -0.5),
    }


def reference(x, attn_norm, w_in, diff_q_norm, diff_k_norm, diff_lam_q1, diff_lam_k1,
              diff_lam_q2, diff_lam_k2, diff_subln, ret_decay_fwd, ret_decay_bwd,
              ret_group_norm, gqa_q_norm, gqa_k_norm, w_branch, w_out, mlp_norm,
              w_mlp_in, w_mlp_out):
    B, S, D = x.shape
    f32 = jnp.float32
    rows = S // GRID_W
    seq_pos = jnp.arange(S, dtype=f32)
    row_pos = jnp.repeat(jnp.arange(rows, dtype=f32), GRID_W)
    col_pos = jnp.tile(jnp.arange(GRID_W, dtype=f32), rows)
    rope_partial = rope_cos_sin(seq_pos, PARTIAL_ROT_DIM, PARTIAL_ROPE_THETA)
    rope_ret = rope_cos_sin(seq_pos, RET_KEY_DIM, RET_ROPE_THETA)
    rope_row = rope_cos_sin(row_pos, AXIAL_DIM, AXIAL_ROPE_THETA)
    rope_col = rope_cos_sin(col_pos, AXIAL_DIM, AXIAL_ROPE_THETA)

    def partial_rope(t):
        return jnp.concatenate([apply_rope(t[..., :PARTIAL_ROT_DIM], rope_partial),
                                t[..., PARTIAL_ROT_DIM:]], axis=-1)

    def axial_rope(t):
        return jnp.concatenate([apply_rope(t[..., :AXIAL_DIM], rope_row),
                                apply_rope(t[..., AXIAL_DIM:], rope_col)], axis=-1)

    h = x
    for l in range(DEPTH):
        u = rms_norm(h, attn_norm[l])
        proj = jnp.einsum('bsd,dc->bsc', u, w_in[l])
        (dq, dk, dv, rq, rk, rv, rg, gq, gk, gv, gate_logits) = split_cols(proj, IN_SPLITS)

        lambda_init = 0.8 - 0.6 * math.exp(-0.3 * l)
        lam = (jnp.exp(jnp.sum(diff_lam_q1[l].astype(f32) * diff_lam_k1[l].astype(f32)))
               - jnp.exp(jnp.sum(diff_lam_q2[l].astype(f32) * diff_lam_k2[l].astype(f32)))
               + lambda_init)
        dq = partial_rope(rms_norm(dq.reshape(B, S, DIFF_HEADS, 2, DIFF_HEAD_DIM), diff_q_norm[l]))
        dk = partial_rope(rms_norm(dk.reshape(B, S, DIFF_HEADS, 2, DIFF_HEAD_DIM), diff_k_norm[l]))
        dv = dv.reshape(B, S, DIFF_HEADS, DIFF_V_DIM)
        a = differential_attention(dq, dk, dv, lam)
        a = (rms_norm(a, diff_subln[l], eps=1e-5) * (1.0 - lambda_init)).reshape(B, S, DIFF_WIDTH)

        rq = apply_rope(rq.reshape(B, S, RET_HEADS, RET_KEY_DIM), rope_ret).astype(f32)
        rk = (apply_rope(rk.reshape(B, S, RET_HEADS, RET_KEY_DIM), rope_ret).astype(f32)
              * (RET_KEY_DIM ** -0.5))
        rv = rv.reshape(B, S, RET_HEADS, RET_VAL_DIM).astype(f32)
        log_fwd = -jnp.exp(ret_decay_fwd[l].astype(f32))
        log_bwd = -jnp.exp(ret_decay_bwd[l].astype(f32))
        r = bidirectional_retention(rq, rk, rv, log_fwd, log_bwd)
        r = (jax.nn.silu(rg.astype(f32)) * head_group_norm(r, ret_group_norm[l])).astype(h.dtype)

        gq = axial_rope(rms_norm(gq.reshape(B, S, GQA_KV_HEADS, GQA_GROUP, GQA_HEAD_DIM), gqa_q_norm[l]))
        gk = axial_rope(rms_norm(gk.reshape(B, S, GQA_KV_HEADS, GQA_HEAD_DIM), gqa_k_norm[l]))
        gv = gv.reshape(B, S, GQA_KV_HEADS, GQA_HEAD_DIM)
        c = grouped_query_attention(gq, gk, gv).reshape(B, S, GQA_WIDTH)

        branches = jnp.stack([a, r, c], axis=2)
        projected = jnp.einsum('bsnw,nwd->bsnd', branches, w_branch[l])
        gates = jax.nn.sigmoid(gate_logits.reshape(B, S, N_BRANCHES, D))
        merged = jnp.sum(gates * projected, axis=2)
        h = h + jnp.einsum('bsd,de->bse', merged, w_out[l])

        m = jnp.einsum('bsd,df->bsf', rms_norm(h, mlp_norm[l]), w_mlp_in[l])
        m = jnp.square(jax.nn.relu(m))
        h = h + jnp.einsum('bsf,fd->bsd', m, w_mlp_out[l])
    return h
```

```cpp
#include <hip/hip_runtime.h>
#include <hip/hip_cooperative_groups.h>
#include <cstdio>
#include <cstdint>
namespace cg = cooperative_groups;

typedef unsigned short u16;
typedef __attribute__((ext_vector_type(8))) short bf16x8;
typedef __attribute__((ext_vector_type(16))) float f32x16;
typedef __attribute__((ext_vector_type(4))) unsigned u32x4;
typedef __attribute__((ext_vector_type(2))) unsigned u32x2;
typedef float f32x4 __attribute__((ext_vector_type(4)));

constexpr int D = 1024, NBATCH = 4, S = 8192, T = NBATCH * S;
constexpr int TH = T / 2;
constexpr int INC = 7424, DFF = 4096;
constexpr int NTHREADS = 512;
constexpr int LDS_BYTES = 147456;
constexpr int LDS_ALLOC = LDS_BYTES + 16;

constexpr size_t MiB = 1ull << 20;
constexpr size_t OFF_U = 0, OFF_DQ = 36 * MiB, OFF_DK = 52 * MiB, OFF_DVT = 68 * MiB, OFF_RQ = 84 * MiB,
                 OFF_RK = 100 * MiB, OFF_RKT = 116 * MiB, OFF_RVT = 132 * MiB, OFF_RG = 148 * MiB, OFF_GQ = 164 * MiB,
                 OFF_GK = 180 * MiB, OFF_GVT = 184 * MiB, OFF_GATES = 188 * MiB, OFF_KVF = 284 * MiB,
                 OFF_KVB = 316 * MiB, OFF_ABUF = 348 * MiB, OFF_WT = 402 * MiB, OFF_TAB = 440 * MiB, OFF_BAR = 446 * MiB, OFF_SP = 447 * MiB;
constexpr int SP_ATTN_NORM = 0, SP_DQN = 2048, SP_DKN = 2176, SP_LQ1 = 2304, SP_LK1 = 2432, SP_LQ2 = 2560, SP_LK2 = 2688,
              SP_SUBLN = 2816, SP_RDF = 3072, SP_RDB = 3080, SP_RGN = 3088, SP_GQN = 4112, SP_GKN = 4240, SP_MLPN = 4368;
#define SPF(p) ((const float*)((p).ws + OFF_SP))
constexpr size_t OFF_MERGED = OFF_DQ, OFF_M = OFF_DQ;
constexpr int LDU = 1088, LDB3 = 576, LDM = 4160;
constexpr long WT_IN = 0, WT_BR = WT_IN + 7424l * LDU, WT_OUT = WT_BR + 3l * 1024 * LDB3, WT_W1 = WT_OUT + 1024l * LDU, WT_W2 = WT_W1 + 4096l * LDU;
constexpr long WT_BR_STRIDE = 1024l * LDB3;
constexpr int TAB_PT = 0, TAB_RT = 65536, TAB_AX = 65536 + 524288, TAB_N = 65536 + 524288 + 2048;

extern __shared__ __attribute__((aligned(16))) char smem_all[];

struct Params {
  const float *x, *attn_norm, *w_in, *dqn, *dkn, *lq1, *lk1, *lq2, *lk2, *subln, *rdf, *rdb, *rgn, *gqn, *gkn,
      *w_branch, *w_out, *mlp_norm, *w1, *w2;
  float* out;
  char* ws;
};

__device__ __forceinline__ int TIDX() { int t = __builtin_amdgcn_workitem_id_x(); asm volatile("" : "+v"(t)); return t; }
__device__ __forceinline__ unsigned cvtpk(float lo, float hi) {
  unsigned r;
  asm("v_cvt_pk_bf16_f32 %0, %1, %2" : "=v"(r) : "v"(lo), "v"(hi));
  return r;
}
__device__ __forceinline__ u16 f2bf(float x) { return (u16)(cvtpk(x, x) & 0xffffu); }
__device__ __forceinline__ float bf2f(u16 v) { return __uint_as_float(((unsigned)v) << 16); }
__device__ __forceinline__ float bflo(unsigned w) { return __uint_as_float(w << 16); }
__device__ __forceinline__ float bfhi(unsigned w) { return __uint_as_float(w & 0xffff0000u); }
__device__ __forceinline__ int crow(int r, int hi) { return (r & 3) + 8 * (r >> 2) + 4 * hi; }
__device__ __forceinline__ float xhalf_sum(float v) {
  auto rr = __builtin_amdgcn_permlane32_swap(__float_as_uint(v), __float_as_uint(v), false, false);
  return __uint_as_float(rr[0]) + __uint_as_float(rr[1]);
}
__device__ __forceinline__ float xhalf_max(float v) {
  auto rr = __builtin_amdgcn_permlane32_swap(__float_as_uint(v), __float_as_uint(v), false, false);
  return fmaxf(__uint_as_float(rr[0]), __uint_as_float(rr[1]));
}
__device__ __forceinline__ float shx(float v, int lane, int m) {
  return __int_as_float(__builtin_amdgcn_ds_bpermute(((lane ^ m) << 2), __float_as_int(v)));
}
__device__ __forceinline__ f32x16 mfma32(bf16x8 a, bf16x8 b, f32x16 c) {
  return __builtin_amdgcn_mfma_f32_32x32x16_bf16(a, b, c, 0, 0, 0);
}
__device__ __forceinline__ u32x2 pack4(float a, float b, float c, float d) {
  u32x2 r; r[0] = cvtpk(a, b); r[1] = cvtpk(c, d); return r;
}

__device__ __forceinline__ void phase_smallparams(const Params& p) {
  if (blockIdx.x != 0) return;
  float* sp = (float*)(p.ws + OFF_SP);
  const int t = TIDX();
  for (int i = t; i < 2048; i += NTHREADS) { sp[SP_ATTN_NORM + i] = p.attn_norm[i]; sp[SP_MLPN + i] = p.mlp_norm[i]; }
  for (int i = t; i < 1024; i += NTHREADS) sp[SP_RGN + i] = p.rgn[i];
  if (t < 256) sp[SP_SUBLN + t] = p.subln[t];
  if (t < 128) { sp[SP_DQN + t] = p.dqn[t]; sp[SP_DKN + t] = p.dkn[t]; sp[SP_LQ1 + t] = p.lq1[t]; sp[SP_LK1 + t] = p.lk1[t];
                 sp[SP_LQ2 + t] = p.lq2[t]; sp[SP_LK2 + t] = p.lk2[t]; sp[SP_GQN + t] = p.gqn[t]; sp[SP_GKN + t] = p.gkn[t]; }
  if (t < 8) { sp[SP_RDF + t] = p.rdf[t]; sp[SP_RDB + t] = p.rdb[t]; }
}

__device__ __forceinline__ void phase_tables(const Params& p) {
  float2* tab = (float2*)(p.ws + OFF_TAB);
  const int nth = gridDim.x * NTHREADS;
  for (int idx = blockIdx.x * NTHREADS + TIDX(); idx < TAB_N; idx += nth) {
    float pos, inv;
    if (idx < TAB_RT) { int s = idx >> 3, i = idx & 7; pos = (float)s; inv = powf(500000.0f, -(float)(2 * i) / 16.0f); }
    else if (idx < TAB_AX) { int k = idx - TAB_RT; int s = k >> 6, i = k & 63; pos = (float)s; inv = powf(10000.0f, -(float)(2 * i) / 128.0f); }
    else { int k = idx - TAB_AX; int s = k >> 4, i = k & 15; pos = (float)s; inv = powf(10000.0f, -(float)(2 * i) / 32.0f); }
    float ang = pos * inv;
    float sn, cs;
    sincosf(ang, &sn, &cs);
    tab[idx] = make_float2(cs, sn);
  }
}

__device__ __forceinline__ int phys_nat(int f);
__device__ __forceinline__ int phys_win(int f);
__device__ __forceinline__ void phase_wconv(const Params& p, int l, char* smem) {
  float* tl = (float*)smem;
  u16* wt = (u16*)(p.ws + OFF_WT);
  const int tid = TIDX();
  for (int t = blockIdx.x; t < 4544; t += gridDim.x) {
    const float* src; u16* dst; int K, N, tt, ldd, kind;
    if (t < 1856) { src = p.w_in + (long)l * D * INC; dst = wt + WT_IN; K = 1024; N = INC; tt = t; ldd = LDU; kind = 2; }
    else if (t < 2240) { int q = t - 1856; int nb = q >> 7; src = p.w_branch + ((long)l * 3 + nb) * 512 * 1024; dst = wt + WT_BR + (long)nb * WT_BR_STRIDE; K = 512; N = 1024; tt = q & 127; ldd = LDB3; kind = 1; }
    else if (t < 2496) { src = p.w_out + (long)l * D * D; dst = wt + WT_OUT; K = 1024; N = 1024; tt = t - 2240; ldd = LDU; kind = 1; }
    else if (t < 3520) { src = p.w1 + (long)l * D * DFF; dst = wt + WT_W1; K = 1024; N = DFF; tt = t - 2496; ldd = LDU; kind = 1; }
    else { src = p.w2 + (long)l * DFF * D; dst = wt + WT_W2; K = DFF; N = 1024; tt = t - 3520; ldd = LDM; kind = 1; }
    const int nkt = K >> 6;
    const int k0 = (tt % nkt) * 64, n0 = (tt / nkt) * 64;
#pragma unroll
    for (int i = 0; i < 2; ++i) {
      int k = (tid >> 4) + 32 * i, n4 = (tid & 15) * 4;
      const f32x4 v_ = __builtin_nontemporal_load((const f32x4*)(src + (long)(k0 + k) * N + n0 + n4)); float4 v; v.x = v_[0]; v.y = v_[1]; v.z = v_[2]; v.w = v_[3];
      tl[(n4 + 0) * 65 + k] = v.x; tl[(n4 + 1) * 65 + k] = v.y; tl[(n4 + 2) * 65 + k] = v.z; tl[(n4 + 3) * 65 + k] = v.w;
    }
    __syncthreads();
    {
      int n = tid >> 3, kc = (tid & 7) * 8;
      const float* r = tl + n * 65 + kc;
      u32x4 w; w[0] = cvtpk(r[0], r[1]); w[1] = cvtpk(r[2], r[3]); w[2] = cvtpk(r[4], r[5]); w[3] = cvtpk(r[6], r[7]);
      const int nl = n0 + n; const int np = (kind == 2) ? phys_win(nl) : ((kind == 1) ? phys_nat(nl) : nl);
      *(u32x4*)(dst + (long)np * ldd + k0 + kc) = w;
    }
    __syncthreads();
  }
}

__device__ __forceinline__ void phase_norm(const Params& p, const float* hin, int tok0, const float* gain) {
  u16* u = (u16*)(p.ws + OFF_U);
  const int lane = TIDX() & 63;
  const int wv = blockIdx.x * 8 + (TIDX() >> 6), nwv = gridDim.x * 8;
  f32x4 g[4];
#pragma unroll
  for (int i = 0; i < 4; ++i) g[i] = *(const f32x4*)(gain + i * 256 + lane * 4);
  for (int t0 = wv * 4; t0 < TH; t0 += nwv * 4) {
    f32x4 v[4][4];
#pragma unroll
    for (int k = 0; k < 4; ++k)
#pragma unroll
      for (int i = 0; i < 4; ++i) v[k][i] = __builtin_nontemporal_load((const f32x4*)(hin + (long)(tok0 + t0 + k) * D + i * 256 + lane * 4));
#pragma unroll
    for (int k = 0; k < 4; ++k) {
      float ss = 0;
#pragma unroll
      for (int i = 0; i < 4; ++i) ss += v[k][i][0] * v[k][i][0] + v[k][i][1] * v[k][i][1] + v[k][i][2] * v[k][i][2] + v[k][i][3] * v[k][i][3];
#pragma unroll
      for (int o = 32; o >= 1; o >>= 1) ss += shx(ss, lane, o);
      const float rstd = rsqrtf(ss * (1.0f / D) + 1e-6f);
#pragma unroll
      for (int i = 0; i < 4; ++i) {
        const f32x4 y = v[k][i] * rstd * g[i];
        *(u32x2*)(u + (long)(t0 + k) * LDU + i * 256 + lane * 4) = pack4(y[0], y[1], y[2], y[3]);
      }
    }
  }
}

#define LAS __attribute__((address_space(3)))
constexpr int PBK = 64, PHALF = 128, HTB = PHALF * PBK * 2;
__device__ __forceinline__ int lds_byte(int r, int c) { const int st = (r >> 4) * 2 + (c >> 5), rr = r & 15, cc = c & 31, ob = rr * 64 + cc * 2; return st * 1024 + (ob ^ (((ob >> 9) & 1) << 5)); }
__device__ __forceinline__ void stage_rc(int b, int& R, int& C) { const int st = b / 1024, sb = b % 1024, swz = sb ^ (((sb >> 9) & 1) << 5); R = (st >> 1) * 16 + swz / 64; C = (st & 1) * 32 + (swz % 64) / 2; }
struct Unit { int pm, pn, nb; };
struct GemmD { const u16* A; const u16* Bt; int K, ld; size_t a_bs, b_bs; };
struct Sched {
  int ntiles, G, c, nbr;
  __device__ __forceinline__ bool next(int i, Unit& u) const {
    const int q = i / nbr;
    const long t = (long)q * G + c; if (t >= ntiles) return false;
    u.nb = i - q * nbr; u.pm = (int)(t & 63); u.pn = (int)(t >> 6); return true;
  }
};

template <class Epi>
__device__ __forceinline__ void gemm_phase(LAS unsigned char* lds, const GemmD g, const Sched& S, const Epi& E) {
  const int tid = TIDX(), wid = __builtin_amdgcn_readfirstlane(tid >> 6), lane = tid & 63, wr = wid >> 2, wc = wid & 3, fr = lane & 15, fq = lane >> 4;
  const int nt = g.K / PBK;
  unsigned voffA[2];
#pragma unroll
  for (int i = 0; i < 2; ++i) { int R, C; stage_rc(tid * 16 + i * 8192, R, C); voffA[i] = (unsigned)(R * g.ld + C) * 2u; }
  const size_t kstep = (size_t)(PBK * 2);
  const size_t hstep = (size_t)PHALF * g.ld * 2;
  const size_t tstep = 2 * hstep;
  const unsigned ldsw = (unsigned)wid * 1024u;
  const int aoff = lds_byte(wr * 64 + fr, fq * 8), boff = lds_byte(wc * 32 + fr, fq * 8);
#define PG8_SA(b, h) (((b) * 2 + (h)) * HTB)
#define PG8_SB(b, h) ((4 + (b) * 2 + (h)) * HTB)
#define PG8_STAGE(bufoff, gbase) do { const char* _gb = (const char*)(gbase); asm volatile("" : "+s"(_gb)); _Pragma("unroll") for (int _i = 0; _i < 2; ++_i) \
    __builtin_amdgcn_global_load_lds((const unsigned*)(_gb + voffA[_i]), (LAS unsigned*)(lds + (bufoff) + ldsw + _i * 8192), 16, 0, 0); } while (0)
#define PG8_LDA(dst, b, h) do { _Pragma("unroll") for (int m = 0; m < 4; ++m) _Pragma("unroll") for (int k = 0; k < 2; ++k) dst[m][k] = *(const LAS bf16x8*)(lds + PG8_SA(b, h) + aoff + m * 2048 + k * 1024); } while (0)
#define PG8_LDB(dst, b, h) do { _Pragma("unroll") for (int n = 0; n < 2; ++n) _Pragma("unroll") for (int k = 0; k < 2; ++k) dst[n][k] = *(const LAS bf16x8*)(lds + PG8_SB(b, h) + boff + n * 2048 + k * 1024); } while (0)
#define PG8_MMA(ai, bj, At, Bt) do { __builtin_amdgcn_s_setprio(1); _Pragma("unroll") for (int m = 0; m < 4; ++m) _Pragma("unroll") for (int n = 0; n < 2; ++n) _Pragma("unroll") for (int k = 0; k < 2; ++k) \
    acc[ai][bj][m][n] = __builtin_amdgcn_mfma_f32_16x16x32_bf16(Bt[n][k], At[m][k], acc[ai][bj][m][n], 0, 0, 0); __builtin_amdgcn_s_setprio(0); } while (0)
#define PG8_WAIT_V(n) asm volatile("s_waitcnt vmcnt(" #n ")" ::: "memory")
#define PG8_WAIT_L(n) asm volatile("s_waitcnt lgkmcnt(" #n ")" ::: "memory")
#define PG8_BAR __builtin_amdgcn_s_barrier()
#define PG8_SCHED __builtin_amdgcn_sched_barrier(0)
  Unit cur, nxt; int ui = 0;
  if (!S.next(0, cur)) return;
  f32x4 acc[2][2][4][2];
#pragma unroll
  for (int a = 0; a < 2; ++a)
#pragma unroll
    for (int b = 0; b < 2; ++b)
#pragma unroll
      for (int m = 0; m < 4; ++m)
#pragma unroll
        for (int n = 0; n < 2; ++n) acc[a][b][m][n] = (f32x4){0.f, 0.f, 0.f, 0.f};
  bf16x8 At[4][2], B0[2][2], B1[2][2];
  const char* cA = (const char*)g.A + (size_t)cur.pm * tstep + (size_t)cur.nb * g.a_bs; const char* cB = (const char*)g.Bt + (size_t)cur.pn * tstep + (size_t)cur.nb * g.b_bs;
  PG8_STAGE(PG8_SB(0, 0), cB); PG8_STAGE(PG8_SA(0, 0), cA); PG8_STAGE(PG8_SB(0, 1), cB + hstep); PG8_STAGE(PG8_SA(0, 1), cA + hstep);
  if (wr == 1) PG8_BAR;
  PG8_WAIT_V(4); PG8_BAR;
  PG8_STAGE(PG8_SB(1, 0), cB + kstep); PG8_STAGE(PG8_SA(1, 0), cA + kstep); PG8_STAGE(PG8_SB(1, 1), cB + hstep + kstep);
  PG8_WAIT_V(6); PG8_BAR;
  for (;;) {
    const bool has_next = S.next(ui + 1, nxt);
    const char* nA = has_next ? (const char*)g.A + (size_t)nxt.pm * tstep + (size_t)nxt.nb * g.a_bs : cA; const char* nB = has_next ? (const char*)g.Bt + (size_t)nxt.pn * tstep + (size_t)nxt.nb * g.b_bs : cB;
    for (int t = 0; t < nt; t += 2) {
      const bool last = (t == nt - 2);
      const char* a1 = cA + (size_t)(t + 1) * kstep;
      const char* a2 = last ? nA : cA + (size_t)(t + 2) * kstep; const char* b2 = last ? nB : cB + (size_t)(t + 2) * kstep;
      const char* a3 = a2 + kstep; const char* b3 = b2 + kstep;
      PG8_LDB(B0, 0, 0); PG8_SCHED; PG8_LDA(At, 0, 0); PG8_STAGE(PG8_SA(1, 1), a1 + hstep);
      PG8_WAIT_L(8); PG8_BAR; PG8_WAIT_L(0); PG8_MMA(0, 0, At, B0); PG8_BAR; PG8_SCHED;
      PG8_LDB(B1, 0, 1); PG8_STAGE(PG8_SB(0, 0), b2);
      PG8_BAR; PG8_WAIT_L(0); PG8_MMA(0, 1, At, B1); PG8_BAR;
      PG8_LDA(At, 0, 1); PG8_STAGE(PG8_SA(0, 0), a2);
      PG8_BAR; PG8_WAIT_L(0); PG8_MMA(1, 0, At, B0); PG8_BAR; PG8_SCHED;
      PG8_STAGE(PG8_SB(0, 1), b2 + hstep);
      PG8_WAIT_V(6); PG8_BAR; PG8_MMA(1, 1, At, B1); PG8_BAR;
      PG8_LDB(B0, 1, 0); PG8_SCHED; PG8_LDA(At, 1, 0); PG8_STAGE(PG8_SA(0, 1), a2 + hstep);
      PG8_WAIT_L(8); PG8_BAR; PG8_WAIT_L(0); PG8_MMA(0, 0, At, B0); PG8_BAR; PG8_SCHED;
      PG8_LDB(B1, 1, 1); PG8_STAGE(PG8_SB(1, 0), b3);
      PG8_BAR; PG8_WAIT_L(0); PG8_MMA(0, 1, At, B1); PG8_BAR;
      PG8_LDA(At, 1, 1); PG8_STAGE(PG8_SA(1, 0), a3);
      PG8_BAR; PG8_WAIT_L(0); PG8_MMA(1, 0, At, B0); PG8_BAR; PG8_SCHED;
      PG8_STAGE(PG8_SB(1, 1), b3 + hstep);
      PG8_WAIT_V(6); PG8_BAR; PG8_MMA(1, 1, At, B1); PG8_BAR;
    }
    E(acc, cur, wr, wc, fr, fq);
    if (!has_next) break;
    if (nxt.nb == 0)
#pragma unroll
    for (int a = 0; a < 2; ++a)
#pragma unroll
      for (int b = 0; b < 2; ++b)
#pragma unroll
        for (int m = 0; m < 4; ++m)
#pragma unroll
          for (int n = 0; n < 2; ++n) acc[a][b][m][n] = (f32x4){0.f, 0.f, 0.f, 0.f};
    cur = nxt; cA = nA; cB = nB; ++ui;
  }
  PG8_WAIT_V(0);
  if (wr == 0) PG8_BAR;
  PG8_BAR;
#undef PG8_SA
#undef PG8_SB
#undef PG8_STAGE
#undef PG8_LDA
#undef PG8_LDB
#undef PG8_MMA
#undef PG8_WAIT_V
#undef PG8_WAIT_L
#undef PG8_BAR
#undef PG8_SCHED
}

__device__ __forceinline__ int rho32(int d) { return ((d >> 2) & 1) * 16 + (d >> 3) * 4 + (d & 3); }
__device__ __forceinline__ int phys_nat(int f) { return (f & ~31) | rho32(f & 31); }
__device__ __forceinline__ int phys_g64(int f) { const int x = f & 255, wc = x >> 6, bj = (x >> 5) & 1; return (f & ~255) + bj * 128 + wc * 32 + rho32(x & 31); }
__device__ __forceinline__ int phys_h128(int f) { const int x = f & 255, hd = x >> 7, bj = (x >> 6) & 1, w1 = (x >> 5) & 1; return (f & ~255) + bj * 128 + (hd * 2 + w1) * 32 + rho32(x & 31); }
__device__ __forceinline__ int phys_win(int f) {
  if (f < 1024) return phys_g64(f);
  if (f < 1536) return phys_nat(f);
  if (f < 2560) return phys_h128(f);
  if (f < 3584) return phys_nat(f);
  if (f < 4352) return phys_g64(f);
  return phys_nat(f);
}

__device__ __forceinline__ u32x4 pack8(const f32x4& a, const f32x4& b) {
  u32x4 w; w[0] = cvtpk(a[0], a[1]); w[1] = cvtpk(a[2], a[3]); w[2] = cvtpk(b[0], b[1]); w[3] = cvtpk(b[2], b[3]); return w;
}

struct EpiResid {
  const float* hin; float* hout; int tok0;
  __device__ __forceinline__ void operator()(const f32x4 (&acc)[2][2][4][2], const Unit& u, int wr, int wc, int fr_, int fq_) const {
    const int ln_ = TIDX() & 63; const int fr = ln_ & 15, fq = ln_ >> 4; (void)fr_; (void)fq_;
#pragma unroll
    for (int ai = 0; ai < 2; ++ai)
#pragma unroll
      for (int m = 0; m < 4; ++m) {
        const long tg = (long)tok0 + u.pm * 256 + ai * 128 + wr * 64 + m * 16 + fr;
#pragma unroll
        for (int bj = 0; bj < 2; ++bj) {
          const int f0 = u.pn * 256 + bj * 128 + wc * 32 + 8 * fq;
          f32x4 h0 = __builtin_nontemporal_load((const f32x4*)(hin + tg * D + f0)), h1 = __builtin_nontemporal_load((const f32x4*)(hin + tg * D + f0 + 4));
          *(f32x4*)(hout + tg * D + f0) = h0 + acc[ai][bj][m][0];
          *(f32x4*)(hout + tg * D + f0 + 4) = h1 + acc[ai][bj][m][1];
        }
      }
  }
};

struct EpiRelu2 {
  u16* mb;
  __device__ __forceinline__ void operator()(const f32x4 (&acc)[2][2][4][2], const Unit& u, int wr, int wc, int fr_, int fq_) const {
    const int ln_ = TIDX() & 63; const int fr = ln_ & 15, fq = ln_ >> 4; (void)fr_; (void)fq_;
#pragma unroll
    for (int ai = 0; ai < 2; ++ai)
#pragma unroll
      for (int m = 0; m < 4; ++m) {
        const long tl = (long)u.pm * 256 + ai * 128 + wr * 64 + m * 16 + fr;
#pragma unroll
        for (int bj = 0; bj < 2; ++bj) {
          f32x4 a = acc[ai][bj][m][0], b = acc[ai][bj][m][1];
#pragma unroll
          for (int j = 0; j < 4; ++j) { float x = fmaxf(a[j], 0.f), y = fmaxf(b[j], 0.f); a[j] = x * x; b[j] = y * y; }
          *(u32x4*)(mb + tl * LDM + u.pn * 256 + bj * 128 + wc * 32 + 8 * fq) = pack8(a, b);
        }
      }
  }
};

__device__ __forceinline__ void load_cs4(const float2* t, f32x4& c, f32x4& sn) {
  const f32x4 a = *(const f32x4*)t, b = *(const f32x4*)(t + 2);
  c[0] = a[0]; sn[0] = a[1]; c[1] = a[2]; sn[1] = a[3]; c[2] = b[0]; sn[2] = b[1]; c[3] = b[2]; sn[3] = b[3];
}
__device__ __forceinline__ void st16(char* base, unsigned off, float v) { *(u16*)(base + off) = f2bf(v); }
struct EpiInproj {
  char* ws; int l;
  __device__ __forceinline__ void operator()(const f32x4 (&acc)[2][2][4][2], const Unit& u, int wr, int wc, int fr_, int fq_) const {
    const int ln_ = TIDX() & 63; const int fr = ln_ & 15, fq = ln_ >> 4; (void)fr_; (void)fq_;
    const float2* tab = (const float2*)(ws + OFF_TAB);
    const float* spf = (const float*)(ws + OFF_SP);
    const int lane = fq * 16 + fr;
    const int pn = u.pn;
    const int tlb = u.pm * 256 + wr * 64 + fr;
    if (pn < 4 || (pn >= 14 && pn <= 16)) {
      const int f0 = pn * 256 + wc * 64;
      if (f0 >= 4224) {
        const int kvh = (f0 - 4224) >> 6;
#pragma unroll
        for (int ai = 0; ai < 2; ++ai)
#pragma unroll
          for (int m = 0; m < 4; ++m) {
            const int tl = tlb + ai * 128 + m * 16, s = tl & (S - 1), bl = tl >> 13;
            const unsigned o0 = (unsigned)(((bl * 2 + kvh) * 64 + 8 * fq) * S + s) * 2u;
#pragma unroll
            for (int bj = 0; bj < 2; ++bj)
#pragma unroll
              for (int n = 0; n < 2; ++n)
#pragma unroll
                for (int j = 0; j < 4; ++j) st16(ws + OFF_GVT, o0 + (unsigned)((bj * 32 + 4 * n + j) * S * 2), acc[ai][bj][m][n][j]);
          }
        return;
      }
      const float* gain; u16* dst; int ldd; bool axial; float qsc = 1.0f;
      if (f0 < 512) { gain = spf + SP_DQN + l * 64; dst = (u16*)(ws + OFF_DQ) + f0; ldd = 512; axial = false; qsc = 0.125f * 1.4426950408889634f; }
      else if (f0 < 1024) { gain = spf + SP_DKN + l * 64; dst = (u16*)(ws + OFF_DK) + (f0 - 512); ldd = 512; axial = false; }
      else if (f0 < 4096) { gain = spf + SP_GQN + l * 64; dst = (u16*)(ws + OFF_GQ) + (f0 - 3584); ldd = 512; axial = true; qsc = 0.125f * 1.4426950408889634f; }
      else { gain = spf + SP_GKN + l * 64; dst = (u16*)(ws + OFF_GK) + (f0 - 4096); ldd = 128; axial = true; }
      f32x4 g[2][2];
#pragma unroll
      for (int bj = 0; bj < 2; ++bj)
#pragma unroll
        for (int n = 0; n < 2; ++n) g[bj][n] = *(const f32x4*)(gain + bj * 32 + 8 * fq + 4 * n);
#pragma unroll
      for (int ai = 0; ai < 2; ++ai)
#pragma unroll
        for (int m = 0; m < 4; ++m) {
          const int tl = tlb + ai * 128 + m * 16, s = tl & (S - 1);
          float ss = 0.f;
#pragma unroll
          for (int bj = 0; bj < 2; ++bj)
#pragma unroll
            for (int n = 0; n < 2; ++n)
#pragma unroll
              for (int j = 0; j < 4; ++j) { const float v = acc[ai][bj][m][n][j]; ss += v * v; }
          ss += shx(ss, lane, 16); ss += shx(ss, lane, 32);
          const float rstd = rsqrtf(ss * (1.0f / 64.0f) + 1e-6f);
          f32x4 y[2][2];
#pragma unroll
          for (int bj = 0; bj < 2; ++bj)
#pragma unroll
            for (int n = 0; n < 2; ++n) y[bj][n] = acc[ai][bj][m][n] * rstd * g[bj][n];
          if (!axial) {
#pragma unroll
            for (int n = 0; n < 2; ++n) {
              f32x4 cc, sn; load_cs4(tab + TAB_PT + s * 8 + 4 * n, cc, sn);
#pragma unroll
              for (int j = 0; j < 4; ++j) {
                const float own = y[0][n][j], oth = shx(own, lane, 16);
                const float r0 = own * cc[j] - oth * sn[j], r1 = own * cc[j] + oth * sn[j];
                y[0][n][j] = (fq == 0) ? r0 : ((fq == 1) ? r1 : own);
              }
            }
          } else {
#pragma unroll
            for (int bj = 0; bj < 2; ++bj)
#pragma unroll
              for (int n = 0; n < 2; ++n) {
                const int pos = (bj == 0) ? (s >> 6) : (s & 63);
                f32x4 cc, sn; load_cs4(tab + TAB_AX + pos * 16 + 8 * (fq & 1) + 4 * n, cc, sn);
#pragma unroll
                for (int j = 0; j < 4; ++j) {
                  const float own = y[bj][n][j], oth = shx(own, lane, 32);
                  y[bj][n][j] = (fq < 2) ? (own * cc[j] - oth * sn[j]) : (own * cc[j] + oth * sn[j]);
                }
              }
          }
#pragma unroll
          for (int bj = 0; bj < 2; ++bj) *(u32x4*)(dst + (long)tl * ldd + bj * 32 + 8 * fq) = pack8(y[bj][0] * qsc, y[bj][1] * qsc);
          __builtin_amdgcn_sched_barrier(0);
        }
    } else if (pn >= 6 && pn < 10) {
      const bool isk = (pn >= 8);
      const int hh = (pn - (isk ? 8 : 6)) * 2 + (wc >> 1), w1 = wc & 1;
      const float sc = isk ? 0.08838834764831845f : 1.0f;
      u16* dstn = (u16*)(ws + (isk ? OFF_RK : OFF_RQ)) + hh * 128 + w1 * 32 + 8 * fq;
#pragma unroll
      for (int ai = 0; ai < 2; ++ai)
#pragma unroll
        for (int m = 0; m < 4; ++m) {
          const int tl = tlb + ai * 128 + m * 16, s = tl & (S - 1), bl = tl >> 13;
          f32x4 y[2][2];
#pragma unroll
          for (int n = 0; n < 2; ++n) {
            f32x4 cc, sn; load_cs4(tab + TAB_RT + s * 64 + w1 * 32 + 8 * fq + 4 * n, cc, sn);
#pragma unroll
            for (int j = 0; j < 4; ++j) {
              const float x1 = acc[ai][0][m][n][j], x2 = acc[ai][1][m][n][j];
              y[0][n][j] = (x1 * cc[j] - x2 * sn[j]) * sc; y[1][n][j] = (x2 * cc[j] + x1 * sn[j]) * sc;
            }
          }
#pragma unroll
          for (int bj = 0; bj < 2; ++bj) *(u32x4*)(dstn + (long)tl * 512 + bj * 64) = pack8(y[bj][0], y[bj][1]);
          if (isk) {
            const unsigned o0 = (unsigned)(((bl * 4 + hh) * 128 + w1 * 32 + 8 * fq) * S + s) * 2u;
#pragma unroll
            for (int bj = 0; bj < 2; ++bj)
#pragma unroll
              for (int n = 0; n < 2; ++n)
#pragma unroll
                for (int j = 0; j < 4; ++j) st16(ws + OFF_RKT, o0 + (unsigned)((bj * 64 + 4 * n + j) * S * 2), y[bj][n][j]);
          }
          __builtin_amdgcn_sched_barrier(0);
        }
    } else if (pn == 4 || pn == 5 || pn == 10 || pn == 11) {
      const bool isd = (pn < 6);
      const int fbase = isd ? 1024 : 2560;
#pragma unroll
      for (int ai = 0; ai < 2; ++ai)
#pragma unroll
        for (int m = 0; m < 4; ++m) {
          const int tl = tlb + ai * 128 + m * 16, s = tl & (S - 1), bl = tl >> 13;
#pragma unroll
          for (int bj = 0; bj < 2; ++bj) {
            const int fl = pn * 256 + bj * 128 + wc * 32 + 8 * fq - fbase;
            const unsigned o0 = (unsigned)((bl * 4 * 128 + fl) * S + s) * 2u;
#pragma unroll
            for (int n = 0; n < 2; ++n)
#pragma unroll
              for (int j = 0; j < 4; ++j) st16(ws + (isd ? OFF_DVT : OFF_RVT), o0 + (unsigned)((4 * n + j) * S * 2), acc[ai][bj][m][n][j]);
          }
        }
    } else if (pn == 12 || pn == 13) {
#pragma unroll
      for (int ai = 0; ai < 2; ++ai)
#pragma unroll
        for (int m = 0; m < 4; ++m) {
          const long tl = tlb + ai * 128 + m * 16;
#pragma unroll
          for (int bj = 0; bj < 2; ++bj) {
            f32x4 a = acc[ai][bj][m][0], b = acc[ai][bj][m][1];
#pragma unroll
            for (int j = 0; j < 4; ++j) { a[j] = a[j] * __builtin_amdgcn_rcpf(1.0f + __expf(-a[j])); b[j] = b[j] * __builtin_amdgcn_rcpf(1.0f + __expf(-b[j])); }
            *(u32x4*)((u16*)(ws + OFF_RG) + tl * 512 + (pn - 12) * 256 + bj * 128 + wc * 32 + 8 * fq) = pack8(a, b);
          }
        }
    } else {
#pragma unroll
      for (int ai = 0; ai < 2; ++ai)
#pragma unroll
        for (int m = 0; m < 4; ++m) {
          const long tl = tlb + ai * 128 + m * 16;
#pragma unroll
          for (int bj = 0; bj < 2; ++bj) {
            f32x4 a = acc[ai][bj][m][0], b = acc[ai][bj][m][1];
            u32x2 w8; w8[0] = 0u; w8[1] = 0u;
#pragma unroll
            for (int j = 0; j < 4; ++j) {
              const unsigned qa = max((unsigned)fmaf(__builtin_amdgcn_rcpf(1.0f + __expf(-a[j])), 255.0f, 0.5f), 1u);
              const unsigned qb = max((unsigned)fmaf(__builtin_amdgcn_rcpf(1.0f + __expf(-b[j])), 255.0f, 0.5f), 1u);
              w8[0] |= qa << (8 * j); w8[1] |= qb << (8 * j);
            }
            *(u32x2*)((unsigned char*)(ws + OFF_GATES) + tl * 3072 + (pn - 17) * 256 + bj * 128 + wc * 32 + 8 * fq) = w8;
          }
        }
    }
  }
};

__device__ __forceinline__ void phase_gemm1(const Params& p, int l, char* smem) {
  GemmD g; g.A = (const u16*)(p.ws + OFF_U); g.Bt = (const u16*)(p.ws + OFF_WT) + WT_IN; g.K = 1024; g.ld = LDU; g.a_bs = 0; g.b_bs = 0;
  Sched sc; sc.ntiles = 29 * 64; sc.G = gridDim.x; sc.c = blockIdx.x; sc.nbr = 1;
  EpiInproj e; e.ws = p.ws; e.l = l;
  gemm_phase(( LAS unsigned char*)smem_all, g, sc, e);
}
__device__ __forceinline__ void phase_gemm_resid(const Params& p, long wt_off, size_t act_off, int K, int ld, const float* hin, int tok0, char* smem) {
  GemmD g; g.A = (const u16*)(p.ws + act_off); g.Bt = (const u16*)(p.ws + OFF_WT) + wt_off; g.K = K; g.ld = ld; g.a_bs = 0; g.b_bs = 0;
  Sched sc; sc.ntiles = 4 * 64; sc.G = gridDim.x; sc.c = blockIdx.x; sc.nbr = 1;
  EpiResid e; e.hin = hin; e.hout = p.out; e.tok0 = tok0;
  gemm_phase((LAS unsigned char*)smem_all, g, sc, e);
}
__device__ __forceinline__ void phase_mlp1(const Params& p, char* smem) {
  GemmD g; g.A = (const u16*)(p.ws + OFF_U); g.Bt = (const u16*)(p.ws + OFF_WT) + WT_W1; g.K = 1024; g.ld = LDU; g.a_bs = 0; g.b_bs = 0;
  Sched sc; sc.ntiles = 16 * 64; sc.G = gridDim.x; sc.c = blockIdx.x; sc.nbr = 1;
  EpiRelu2 e; e.mb = (u16*)(p.ws + OFF_M);
  gemm_phase((LAS unsigned char*)smem_all, g, sc, e);
}

struct EpiBranch {
  const unsigned char* gates; u16* merged;
  __device__ __forceinline__ void operator()(f32x4 (&acc)[2][2][4][2], const Unit& u, int wr, int wc, int fr_, int fq_) const {
    const int ln_ = TIDX() & 63; const int fr = ln_ & 15, fq = ln_ >> 4; (void)fr_; (void)fq_;
#pragma unroll
    for (int ai = 0; ai < 2; ++ai)
#pragma unroll
      for (int m = 0; m < 4; ++m) {
        const long tl = (long)u.pm * 256 + ai * 128 + wr * 64 + m * 16 + fr;
#pragma unroll
        for (int bj = 0; bj < 2; ++bj) {
          const int f0 = u.pn * 256 + bj * 128 + wc * 32 + 8 * fq;
          const unsigned char* gp = gates + tl * 3072 + f0 + u.nb * 1024;
          const u32x2 gn = __builtin_nontemporal_load((const u32x2*)gp);
          float sc[8];
#pragma unroll
          for (int i = 0; i < 8; ++i) sc[i] = (float)((gn[i >> 2] >> (8 * (i & 3))) & 255u);
          if (u.nb < 2) {
            const u32x2 gx = __builtin_nontemporal_load((const u32x2*)(gp + 1024));
#pragma unroll
            for (int i = 0; i < 8; ++i) sc[i] *= __builtin_amdgcn_rcpf((float)((gx[i >> 2] >> (8 * (i & 3))) & 255u));
          } else {
#pragma unroll
            for (int i = 0; i < 8; ++i) sc[i] *= (1.0f / 255.0f);
          }
#pragma unroll
          for (int j = 0; j < 4; ++j) { acc[ai][bj][m][0][j] *= sc[j]; acc[ai][bj][m][1][j] *= sc[4 + j]; }
          if (u.nb == 2) *(u32x4*)(merged + tl * LDU + f0) = pack8(acc[ai][bj][m][0], acc[ai][bj][m][1]);
        }
      }
  }
};
__device__ __forceinline__ void phase_branch(const Params& p, char* smem) {
  GemmD g; g.A = (const u16*)(p.ws + OFF_ABUF); g.Bt = (const u16*)(p.ws + OFF_WT) + WT_BR; g.K = 512; g.ld = LDB3;
  g.a_bs = (size_t)TH * LDB3 * 2; g.b_bs = (size_t)WT_BR_STRIDE * 2;
  Sched sc; sc.ntiles = 4 * 64; sc.G = gridDim.x; sc.c = blockIdx.x; sc.nbr = 3;
  EpiBranch e; e.gates = (const unsigned char*)(p.ws + OFF_GATES); e.merged = (u16*)(p.ws + OFF_MERGED);
  gemm_phase((LAS unsigned char*)smem_all, g, sc, e);
}

constexpr int AKT = 64 * 72, AVT = 128 * 72;
constexpr int ATT_STASH_OFF = 2 * (AKT + AVT) * 2;

__device__ __forceinline__ void qk_tile(f32x16& p0, f32x16& p1, const u16* kb, const bf16x8 (&qf)[4], int prow, int hi) {
  p0 = f32x16{}; p1 = f32x16{};
#pragma unroll
  for (int ds = 0; ds < 4; ++ds) {
    bf16x8 k0 = *(const bf16x8*)(kb + prow * 72 + ds * 16 + hi * 8);
    bf16x8 k1 = *(const bf16x8*)(kb + (32 + prow) * 72 + ds * 16 + hi * 8);
    p0 = mfma32(k0, qf[ds], p0);
    p1 = mfma32(k1, qf[ds], p1);
  }
}

template <int DV, bool PIPE, int MODE>
__device__ __forceinline__ void flash_loop(f32x16 (&o)[DV / 32], float& l_run, const u16* __restrict__ qrow,
                                           const u16* __restrict__ kbase, int ldk, const u16* __restrict__ vtbase, u16* lds) {
  constexpr int NDV = DV / 32;
  constexpr float C = (MODE == 0) ? 0.125f * 1.4426950408889634f : 1.0f;
  constexpr float THR = 8.0f / C;
  u16* kl = lds;
  u16* vl = lds + 2 * AKT;
  const int tid = TIDX(), lane = tid & 63, r32 = lane & 31, hi = lane >> 5;
  bf16x8 qf[4];
#pragma unroll
  for (int ds = 0; ds < 4; ++ds) qf[ds] = *(const bf16x8*)(qrow + ds * 16 + hi * 8);
  const int srow = tid >> 3, sc = (tid & 7) * 8;
  const unsigned kofs = (unsigned)(srow * ldk + sc) * 2u, vofs = (unsigned)(srow * S + sc) * 2u;
#define KG(j) ((const char*)(kbase + (long)(j) * 64 * ldk) + kofs)
#define VG(j) ((const char*)(vtbase + (long)(j) * 64) + vofs)
#define VG2(j) ((const char*)(vtbase + 64l * S + (long)(j) * 64) + vofs)
  bf16x8 kr, vr0, vr1;
  const int prow = (r32 & ~12) | ((r32 & 4) << 1) | ((r32 & 8) >> 1);
  float m_run = -1e30f;
  l_run = 0.0f;
#pragma unroll
  for (int d = 0; d < NDV; ++d) o[d] = f32x16{};
  constexpr int NT = S / 64;
  {
    bf16x8 k0 = *(const bf16x8*)KG(0), k1;
    if (PIPE) k1 = *(const bf16x8*)KG(1);
    vr0 = *(const bf16x8*)VG(0);
    if (DV == 128) vr1 = *(const bf16x8*)VG2(0);
    *(bf16x8*)(kl + srow * 72 + sc) = k0;
    if (PIPE) *(bf16x8*)(kl + AKT + srow * 72 + sc) = k1;
    *(bf16x8*)(vl + srow * 72 + sc) = vr0;
    if (DV == 128) *(bf16x8*)(vl + (64 + srow) * 72 + sc) = vr1;
  }
  __syncthreads();
  f32x16 pA0, pA1, pB0, pB1;
  if (PIPE) {
    qk_tile(pA0, pA1, kl, qf, prow, hi);
    asm volatile("s_waitcnt lgkmcnt(0)" ::: "memory"); __builtin_amdgcn_s_barrier(); asm volatile("" ::: "memory");
  }
#define FL_QKBLOCK(D0, D1)                                                                                       \
      f32x16 q0 = f32x16{}, q1 = f32x16{};                                                                       \
      _Pragma("unroll") for (int ds = 0; ds < 4; ++ds) { q0 = mfma32(kf[2 * ds], qf[ds], q0); q1 = mfma32(kf[2 * ds + 1], qf[ds], q1); } \
      D0 = q0; D1 = q1;
#define FL_BODY(PC0, PC1, PN0, PN1, J)                                                                           \
  {                                                                                                              \
    const int j_ = (J);                                                                                          \
    if (PIPE) { if (j_ + 2 < NT) kr = *(const bf16x8*)KG(j_ + 2); } else { if (j_ + 1 < NT) kr = *(const bf16x8*)KG(j_ + 1); } \
    if (j_ + 1 < NT) {                                                                                           \
      vr0 = *(const bf16x8*)VG(j_ + 1);                                                                          \
      if (DV == 128) vr1 = *(const bf16x8*)VG2(j_ + 1);                                                          \
    }                                                                                                            \
    const u16* kb = kl + ((PIPE ? (j_ + 1) : j_) & 1) * AKT;                                                     \
    const u16* vb = vl + (j_ & 1) * AVT;                                                                         \
    bf16x8 kf[8], vf[2][NDV];                                                                                    \
    _Pragma("unroll") for (int ds = 0; ds < 4; ++ds) {                                                           \
      kf[2 * ds] = *(const bf16x8*)(kb + prow * 72 + ds * 16 + hi * 8);                                          \
      kf[2 * ds + 1] = *(const bf16x8*)(kb + (32 + prow) * 72 + ds * 16 + hi * 8);                               \
    }                                                                                                            \
    _Pragma("unroll") for (int d = 0; d < NDV; ++d) vf[0][d] = *(const bf16x8*)(vb + (d * 32 + r32) * 72 + hi * 8);  \
    __builtin_amdgcn_sched_barrier(0);                                                                           \
    if (!PIPE) { FL_QKBLOCK(PC0, PC1) }                                                                          \
    if (PIPE && DV != 64) { if (j_ + 1 < NT) { FL_QKBLOCK(PN0, PN1) } }                                          \
    float ps = 0.0f;                                                                                             \
    if (MODE == 2) {                                                                                             \
      _Pragma("unroll") for (int r = 0; r < 16; ++r) { PC0[r] = __builtin_amdgcn_exp2f(PC0[r]); ps += PC0[r]; }  \
      _Pragma("unroll") for (int r = 0; r < 16; ++r) { PC1[r] = __builtin_amdgcn_exp2f(PC1[r]); ps += PC1[r]; }  \
    } else {                                                                                                     \
    float mx = PC0[0];                                                                                           \
    _Pragma("unroll") for (int r = 1; r < 16; ++r) mx = fmaxf(mx, PC0[r]);                                       \
    _Pragma("unroll") for (int r = 0; r < 16; ++r) mx = fmaxf(mx, PC1[r]);                                       \
    mx = xhalf_max(mx);                                                                                          \
    if (!__all(mx - m_run <= THR)) {                                                                             \
      const float mn = fmaxf(m_run, mx);                                                                         \
      const float alpha = __builtin_amdgcn_exp2f((m_run - mn) * C);                                              \
      m_run = mn;                                                                                                \
      l_run *= alpha;                                                                                            \
      _Pragma("unroll") for (int d = 0; d < NDV; ++d)                                                            \
        _Pragma("unroll") for (int r = 0; r < 16; ++r) o[d][r] *= alpha;                                         \
    }                                                                                                            \
    const float mnC = -m_run * C;                                                                                \
    _Pragma("unroll") for (int r = 0; r < 16; ++r) { PC0[r] = __builtin_amdgcn_exp2f(fmaf(PC0[r], C, mnC)); ps += PC0[r]; } \
    _Pragma("unroll") for (int r = 0; r < 16; ++r) { PC1[r] = __builtin_amdgcn_exp2f(fmaf(PC1[r], C, mnC)); ps += PC1[r]; } \
    }                                                                                                            \
    if (MODE != 2) ps = xhalf_sum(ps);        \
    l_run += ps;                                                                                                 \
    bf16x8 pb[4];                                                                                                \
    {                                                                                                            \
      u32x4 w;                                                                                                   \
      w[0] = cvtpk(PC0[0], PC0[1]); w[1] = cvtpk(PC0[2], PC0[3]); w[2] = cvtpk(PC0[4], PC0[5]); w[3] = cvtpk(PC0[6], PC0[7]);       \
      pb[0] = *reinterpret_cast<bf16x8*>(&w);                                                                    \
      w[0] = cvtpk(PC0[8], PC0[9]); w[1] = cvtpk(PC0[10], PC0[11]); w[2] = cvtpk(PC0[12], PC0[13]); w[3] = cvtpk(PC0[14], PC0[15]); \
      pb[1] = *reinterpret_cast<bf16x8*>(&w);                                                                    \
      w[0] = cvtpk(PC1[0], PC1[1]); w[1] = cvtpk(PC1[2], PC1[3]); w[2] = cvtpk(PC1[4], PC1[5]); w[3] = cvtpk(PC1[6], PC1[7]);       \
      pb[2] = *reinterpret_cast<bf16x8*>(&w);                                                                    \
      w[0] = cvtpk(PC1[8], PC1[9]); w[1] = cvtpk(PC1[10], PC1[11]); w[2] = cvtpk(PC1[12], PC1[13]); w[3] = cvtpk(PC1[14], PC1[15]); \
      pb[3] = *reinterpret_cast<bf16x8*>(&w);                                                                    \
    }                                                                                                            \
    __builtin_amdgcn_sched_barrier(0);                                                                           \
    if (PIPE && DV == 64) { if (j_ + 1 < NT) { FL_QKBLOCK(PN0, PN1) } }     \
    _Pragma("unroll") for (int kk = 0; kk < 4; ++kk) {                                                           \
      if (kk + 1 < 4) {                                                                                          \
        _Pragma("unroll") for (int d = 0; d < NDV; ++d)                                                          \
          vf[(kk + 1) & 1][d] = *(const bf16x8*)(vb + (d * 32 + r32) * 72 + (kk + 1) * 16 + hi * 8);            \
      }                                                                                                          \
      __builtin_amdgcn_sched_barrier(0);                                                                         \
      _Pragma("unroll") for (int d = 0; d < NDV; ++d) o[d] = mfma32(vf[kk & 1][d], pb[kk], o[d]);                \
      __builtin_amdgcn_sched_barrier(0);                                                                         \
    }                                                                                                            \
    if (PIPE) { if (j_ + 2 < NT) *(bf16x8*)(kl + (j_ & 1) * AKT + srow * 72 + sc) = kr; } else { if (j_ + 1 < NT) *(bf16x8*)(kl + ((j_ + 1) & 1) * AKT + srow * 72 + sc) = kr; } \
    if (j_ + 1 < NT) {                                                                                           \
      const int b_ = (j_ + 1) & 1;                                                                               \
      *(bf16x8*)(vl + b_ * AVT + srow * 72 + sc) = vr0;                                                          \
      if (DV == 128) *(bf16x8*)(vl + b_ * AVT + (64 + srow) * 72 + sc) = vr1;                                    \
    }                                                                                                            \
    __syncthreads();                                                                                             \
  }
  for (int j = 0; j < NT; j += 2) {
    FL_BODY(pA0, pA1, pB0, pB1, j)
    FL_BODY(pB0, pB1, pA0, pA1, j + 1)
  }
#undef FL_BODY
#undef FL_QKBLOCK
  if (MODE == 2) l_run = xhalf_sum(l_run);
#undef KG
#undef VG
#undef VG2
}

__device__ __forceinline__ void attn_diff_item(const Params& p, int l, int item, char* smem) {
  const int qt = item & 31, hh = (item >> 5) & 3, bl = item >> 7;
  const int tid = TIDX(), lane = tid & 63, wid = tid >> 6, r32 = lane & 31, hi = lane >> 5;
#define ATT_TL() (bl * S + qt * 256 + (TIDX() >> 6) * 32 + (TIDX() & 31))
  const u16* dq = (const u16*)(p.ws + OFF_DQ);
  const u16* dk = (const u16*)(p.ws + OFF_DK);
  const u16* dvt = (const u16*)(p.ws + OFF_DVT) + ((long)(bl * 4 + hh) * 128) * S;
  unsigned* stash = (unsigned*)(smem + ATT_STASH_OFF) + wid * 2048;
  f32x16 o[4]; float lr;
  float bq = 0.f, bk = 0.f;
  for (int i = 0; i < 64; ++i) { bq = fmaxf(bq, fabsf((SPF(p) + SP_DQN)[l * 64 + i])); bk = fmaxf(bk, fabsf((SPF(p) + SP_DKN)[l * 64 + i])); }
  const bool small = (8.0f * bq * bk < 40.0f);
  if (small) flash_loop<128, true, 2>(o, lr, dq + (long)ATT_TL() * 512 + (hh * 2) * 64, dk + (long)(bl * S) * 512 + (hh * 2) * 64, 512, dvt, (u16*)smem);
  else flash_loop<128, false, 1>(o, lr, dq + (long)ATT_TL() * 512 + (hh * 2) * 64, dk + (long)(bl * S) * 512 + (hh * 2) * 64, 512, dvt, (u16*)smem);
  {
    const float inv = 1.0f / lr;
#pragma unroll
    for (int d = 0; d < 4; ++d)
#pragma unroll
      for (int pr = 0; pr < 8; ++pr) stash[(d * 8 + pr) * 64 + lane] = cvtpk(o[d][2 * pr] * inv, o[d][2 * pr + 1] * inv);
  }
  if (small) flash_loop<128, true, 2>(o, lr, dq + (long)ATT_TL() * 512 + (hh * 2 + 1) * 64, dk + (long)(bl * S) * 512 + (hh * 2 + 1) * 64, 512, dvt, (u16*)smem);
  else flash_loop<128, false, 1>(o, lr, dq + (long)ATT_TL() * 512 + (hh * 2 + 1) * 64, dk + (long)(bl * S) * 512 + (hh * 2 + 1) * 64, 512, dvt, (u16*)smem);
  float s1 = 0, s2 = 0;
  for (int i = 0; i < 64; ++i) { s1 += (SPF(p) + SP_LQ1)[l * 64 + i] * (SPF(p) + SP_LK1)[l * 64 + i]; s2 += (SPF(p) + SP_LQ2)[l * 64 + i] * (SPF(p) + SP_LK2)[l * 64 + i]; }
  int ll = l; asm volatile("" : "+s"(ll));
  const float lambda_init = (ll == 0) ? 0.2f : (0.8f - 0.6f * 0.7408182206817179f);
  const float lam = expf(s1) - expf(s2) + lambda_init;
  const float inv2 = lam / lr;
  float ss = 0;
#pragma unroll
  for (int d = 0; d < 4; ++d)
#pragma unroll
    for (int pr = 0; pr < 8; ++pr) {
      unsigned w = stash[(d * 8 + pr) * 64 + lane];
      float a0 = bflo(w) - inv2 * o[d][2 * pr], a1 = bfhi(w) - inv2 * o[d][2 * pr + 1];
      o[d][2 * pr] = a0; o[d][2 * pr + 1] = a1; ss += a0 * a0 + a1 * a1;
    }
  ss = xhalf_sum(ss);
  const float rstd = rsqrtf(ss * (1.0f / 128.0f) + 1e-5f) * (1.0f - lambda_init);
  const float* sg = (SPF(p) + SP_SUBLN) + l * 128;
  u16* dst = (u16*)(p.ws + OFF_ABUF) + (long)ATT_TL() * LDB3 + hh * 128;
#pragma unroll
  for (int d = 0; d < 4; ++d)
#pragma unroll
    for (int q4 = 0; q4 < 4; ++q4) {
      const int dv0 = d * 32 + 8 * q4 + 4 * hi;
      float4 g = *(const float4*)(sg + dv0);
      *(u32x2*)(dst + dv0) = pack4(o[d][4 * q4] * rstd * g.x, o[d][4 * q4 + 1] * rstd * g.y, o[d][4 * q4 + 2] * rstd * g.z, o[d][4 * q4 + 3] * rstd * g.w);
    }
}
#undef ATT_TL

__device__ __forceinline__ void attn_gqa_item(const Params& p, int l, int item, char* smem) {
  const int qt = item & 31, qh = (item >> 5) & 7, bl = item >> 8;
  const int tid = TIDX(), lane = tid & 63, wid = tid >> 6, r32 = lane & 31, hi = lane >> 5;
  const int tl = bl * S + qt * 256 + wid * 32 + r32;
  const int kvh = qh >> 2;
  const u16* gq = (const u16*)(p.ws + OFF_GQ);
  const u16* gk = (const u16*)(p.ws + OFF_GK);
  const u16* gvt = (const u16*)(p.ws + OFF_GVT) + ((long)(bl * 2 + kvh) * 64) * S;
  f32x16 o[2]; float lr;
  float bq = 0.f, bk = 0.f;
  for (int i = 0; i < 64; ++i) { bq = fmaxf(bq, fabsf((SPF(p) + SP_GQN)[l * 64 + i])); bk = fmaxf(bk, fabsf((SPF(p) + SP_GKN)[l * 64 + i])); }
  if (8.0f * bq * bk < 40.0f)
    flash_loop<64, true, 2>(o, lr, gq + (long)tl * 512 + qh * 64, gk + (long)(bl * S) * 128 + kvh * 64, 128, gvt, (u16*)smem);
  else
    flash_loop<64, true, 1>(o, lr, gq + (long)tl * 512 + qh * 64, gk + (long)(bl * S) * 128 + kvh * 64, 128, gvt, (u16*)smem);
  const float inv = 1.0f / lr;
  u16* dst = (u16*)(p.ws + OFF_ABUF) + 2l * TH * LDB3 + (long)tl * LDB3 + qh * 64;
#pragma unroll
  for (int d = 0; d < 2; ++d)
#pragma unroll
    for (int q4 = 0; q4 < 4; ++q4)
      *(u32x2*)(dst + d * 32 + 8 * q4 + 4 * hi) = pack4(o[d][4 * q4] * inv, o[d][4 * q4 + 1] * inv, o[d][4 * q4 + 2] * inv, o[d][4 * q4 + 3] * inv);
}

constexpr int RROW = 136;
constexpr int RBUF = 128 * RROW;

__device__ __forceinline__ void mm128(f32x16 (&acc)[2], const u16* Al, const u16* Bl) {
  const int lane = TIDX() & 63, wid = TIDX() >> 6, r32 = lane & 31, hi = lane >> 5;
  const int wm = wid >> 2, wn = wid & 3;
#pragma unroll
  for (int ks = 0; ks < 8; ++ks) {
    bf16x8 bfr = *(const bf16x8*)(Bl + (wn * 32 + r32) * RROW + ks * 16 + hi * 8);
#pragma unroll
    for (int mt = 0; mt < 2; ++mt) {
      bf16x8 af = *(const bf16x8*)(Al + (wm * 64 + mt * 32 + r32) * RROW + ks * 16 + hi * 8);
      acc[mt] = mfma32(af, bfr, acc[mt]);
    }
  }
}

__device__ __forceinline__ void stage128(u16* dstl, const u16* src, long ld) {
  const int row = TIDX() >> 2, c = (TIDX() & 3) * 32;
  const u16* s = src + (long)row * ld + c;
  bf16x8 v0 = __builtin_nontemporal_load((const bf16x8*)s), v1 = __builtin_nontemporal_load((const bf16x8*)(s + 8)), v2 = __builtin_nontemporal_load((const bf16x8*)(s + 16)), v3 = __builtin_nontemporal_load((const bf16x8*)(s + 24));
  u16* d = dstl + row * RROW + c;
  *(bf16x8*)d = v0; *(bf16x8*)(d + 8) = v1; *(bf16x8*)(d + 16) = v2; *(bf16x8*)(d + 24) = v3;
}
__device__ __forceinline__ void stage128_f32(u16* dstl, const float* src) {
  const int row = TIDX() >> 2, c = (TIDX() & 3) * 32;
  const float* s = src + row * 128 + c;
  u16* d = dstl + row * RROW + c;
#pragma unroll
  for (int i = 0; i < 4; ++i) {
    float4 a = *(const float4*)(s + 8 * i), b = *(const float4*)(s + 8 * i + 4);
    u32x4 w; w[0] = cvtpk(a.x, a.y); w[1] = cvtpk(a.z, a.w); w[2] = cvtpk(b.x, b.y); w[3] = cvtpk(b.z, b.w);
    *(u32x4*)(d + 8 * i) = w;
  }
}

__device__ __forceinline__ void phase_r1(const Params& p, int l, char* smem) {
  u16* B0 = (u16*)smem;
  u16* B1 = B0 + RBUF;
  u16* B2 = B1 + RBUF;
  float* zf = (float*)(smem + 3 * RBUF * 2);
  float* zb = zf + 128;
  const int tid = TIDX(), lane = tid & 63, wid = tid >> 6, r32 = lane & 31, hi = lane >> 5;
  const int wm = wid >> 2, wn = wid & 3;
  for (int item = blockIdx.x; item < 512; item += gridDim.x) {
    const int n = item & 63, bh = item >> 6, hh = bh & 3;
    const float lf = -expf((SPF(p) + SP_RDF)[l * 4 + hh]), lb = -expf((SPF(p) + SP_RDB)[l * 4 + hh]);
    if (tid < 128) { zf[tid] = expf((float)(127 - tid) * lf); zb[tid] = expf((float)tid * lb); }
    const u16* vsrc = (const u16*)(p.ws + OFF_RVT) + ((long)bh * 128) * S + n * 128;
    const u16* ksrc = (const u16*)(p.ws + OFF_RKT) + ((long)bh * 128) * S + n * 128;
    stage128(B0, vsrc, S);
    __syncthreads();
    {
      const int row = tid >> 2, c = (tid & 3) * 32;
      const u16* s = ksrc + (long)row * S + c;
#pragma unroll
      for (int i = 0; i < 4; ++i) {
        u32x4 v = __builtin_nontemporal_load((const u32x4*)(s + 8 * i));
        u32x4 wf_, wb_;
#pragma unroll
        for (int q = 0; q < 4; ++q) {
          const int j = c + 8 * i + 2 * q;
          float a = bflo(v[q]), b = bfhi(v[q]);
          wf_[q] = cvtpk(a * zf[j], b * zf[j + 1]);
          wb_[q] = cvtpk(a * zb[j], b * zb[j + 1]);
        }
        *(u32x4*)(B1 + row * RROW + c + 8 * i) = wf_;
        *(u32x4*)(B2 + row * RROW + c + 8 * i) = wb_;
      }
    }
    __syncthreads();
    f32x16 af[2], ab[2];
    af[0] = f32x16{}; af[1] = f32x16{}; ab[0] = f32x16{}; ab[1] = f32x16{};
    mm128(af, B0, B1);
    mm128(ab, B0, B2);
    u16* of = (u16*)(p.ws + OFF_KVF) + (long)item * 16384;
    u16* ob = (u16*)(p.ws + OFF_KVB) + (long)item * 16384;
#pragma unroll
    for (int mt = 0; mt < 2; ++mt)
#pragma unroll
      for (int r = 0; r < 16; ++r) {
        const int e = wm * 64 + mt * 32 + crow(r, hi), d = wn * 32 + r32;
        of[e * 128 + d] = f2bf(af[mt][r]);
        ob[e * 128 + d] = f2bf(ab[mt][r]);
      }
    __syncthreads();
  }
}

__device__ __forceinline__ void phase_r2(const Params& p, int l) {
  const int nth = gridDim.x * NTHREADS;
  for (int idx = blockIdx.x * NTHREADS + TIDX(); idx < 65536; idx += nth) {
    const int dir = idx >> 15, e4 = idx & 32767, bh = e4 >> 12, ed = (e4 & 4095) * 4, hh = bh & 3;
    u16* base = (u16*)(p.ws + (dir ? OFF_KVB : OFF_KVF)) + ((long)bh * 64) * 16384 + ed;
    const float lg = -expf((dir ? (SPF(p) + SP_RDB) : (SPF(p) + SP_RDF))[l * 4 + hh]);
    const float dec = expf(128.0f * lg);
    float s0 = 0.f, s1 = 0.f, s2 = 0.f, s3 = 0.f;
    for (int nb = 0; nb < 8; ++nb) {
      u32x2 t[8];
#pragma unroll
      for (int i = 0; i < 8; ++i) { int n = nb * 8 + i; if (dir) n = 63 - n; t[i] = __builtin_nontemporal_load((const u32x2*)(base + (long)n * 16384)); }
#pragma unroll
      for (int i = 0; i < 8; ++i) {
        int n = nb * 8 + i; if (dir) n = 63 - n;
        u32x2 w; w[0] = cvtpk(s0, s1); w[1] = cvtpk(s2, s3);
        *(u32x2*)(base + (long)n * 16384) = w;
        s0 = s0 * dec + bflo(t[i][0]); s1 = s1 * dec + bfhi(t[i][0]); s2 = s2 * dec + bflo(t[i][1]); s3 = s3 * dec + bfhi(t[i][1]);
      }
    }
  }
}

__device__ __forceinline__ void ret_r3_item(const Params& p, int l, int item, char* smem) {
  u16* B0 = (u16*)smem;
  u16* B1 = B0 + RBUF;
  u16* B2 = B1 + RBUF;
  u16* B3 = B2 + RBUF;
  float* OL = (float*)B1;
  const int tid = TIDX(), lane = tid & 63, wid = tid >> 6, r32 = lane & 31, hi = lane >> 5;
  const int wm = wid >> 2, wn = wid & 3;
  const int n = item & 63, bh = item >> 6, hh = bh & 3, bl = bh >> 2;
  const float lf = -expf((SPF(p) + SP_RDF)[l * 4 + hh]), lb = -expf((SPF(p) + SP_RDB)[l * 4 + hh]);
  const long tl0 = (long)bl * S + n * 128;
  stage128(B0, (const u16*)(p.ws + OFF_RQ) + tl0 * 512 + hh * 128, 512);
  stage128(B1, (const u16*)(p.ws + OFF_RK) + tl0 * 512 + hh * 128, 512);
  stage128(B2, (const u16*)(p.ws + OFF_RVT) + ((long)bh * 128) * S + n * 128, S);
  stage128(B3, (const u16*)(p.ws + OFF_KVF) + (long)item * 16384, 128);
  __syncthreads();
  f32x16 sc[2], cr[2], out[2];
  sc[0] = f32x16{}; sc[1] = f32x16{}; cr[0] = f32x16{}; cr[1] = f32x16{};
  mm128(sc, B0, B1);
  mm128(cr, B0, B3);
#pragma unroll
  for (int mt = 0; mt < 2; ++mt)
#pragma unroll
    for (int r = 0; r < 16; ++r) {
      const int i = wm * 64 + mt * 32 + crow(r, hi);
      out[mt][r] = __expf((float)(i + 1) * lf) * cr[mt][r];
    }
  __syncthreads();
#pragma unroll
  for (int mt = 0; mt < 2; ++mt)
#pragma unroll
    for (int r = 0; r < 16; ++r) {
      const int i = wm * 64 + mt * 32 + crow(r, hi), j = wn * 32 + r32;
      const float dd = (float)(i - j);
      const float dec = (i >= j) ? __expf(dd * lf) : __expf(-dd * lb);
      B1[i * RROW + j] = f2bf(sc[mt][r] * dec);
    }
  stage128(B3, (const u16*)(p.ws + OFF_KVB) + (long)item * 16384, 128);
  __syncthreads();
  cr[0] = f32x16{}; cr[1] = f32x16{};
  mm128(out, B1, B2);
  mm128(cr, B0, B3);
#pragma unroll
  for (int mt = 0; mt < 2; ++mt)
#pragma unroll
    for (int r = 0; r < 16; ++r) {
      const int i = wm * 64 + mt * 32 + crow(r, hi);
      out[mt][r] += __expf((float)(128 - i) * lb) * cr[mt][r];
    }
  __syncthreads();
#pragma unroll
  for (int mt = 0; mt < 2; ++mt)
#pragma unroll
    for (int r = 0; r < 16; ++r) {
      const int i = wm * 64 + mt * 32 + crow(r, hi), e = wn * 32 + r32;
      OL[i * 132 + e] = out[mt][r];
    }
  __syncthreads();
  {
    const int i = tid >> 2, qd = tid & 3;
    float xv[32];
    float sm = 0;
#pragma unroll
    for (int k = 0; k < 8; ++k) {
      float4 v = *(const float4*)(OL + i * 132 + qd * 32 + 4 * k);
      xv[4 * k] = v.x; xv[4 * k + 1] = v.y; xv[4 * k + 2] = v.z; xv[4 * k + 3] = v.w;
      sm += v.x + v.y + v.z + v.w;
    }
    sm += shx(sm, lane, 1); sm += shx(sm, lane, 2);
    const float mu = sm * (1.0f / 128.0f);
    float vs = 0;
#pragma unroll
    for (int k = 0; k < 32; ++k) { float dlt = xv[k] - mu; vs += dlt * dlt; }
    vs += shx(vs, lane, 1); vs += shx(vs, lane, 2);
    const float rstd = rsqrtf(vs * (1.0f / 128.0f) + 1e-5f);
    const float* gn = (SPF(p) + SP_RGN) + l * 512 + hh * 128 + qd * 32;
    const u16* rg = (const u16*)(p.ws + OFF_RG) + (tl0 + i) * 512 + hh * 128 + qd * 32;
    u16* dst = (u16*)(p.ws + OFF_ABUF) + 1l * TH * LDB3 + (tl0 + i) * LDB3 + hh * 128 + qd * 32;
#pragma unroll
    for (int k = 0; k < 4; ++k) {
      u32x4 gv = *(const u32x4*)(rg + 8 * k);
      float4 g0 = *(const float4*)(gn + 8 * k), g1 = *(const float4*)(gn + 8 * k + 4);
      u32x4 w;
      w[0] = cvtpk((xv[8 * k + 0] - mu) * rstd * g0.x * bflo(gv[0]), (xv[8 * k + 1] - mu) * rstd * g0.y * bfhi(gv[0]));
      w[1] = cvtpk((xv[8 * k + 2] - mu) * rstd * g0.z * bflo(gv[1]), (xv[8 * k + 3] - mu) * rstd * g0.w * bfhi(gv[1]));
      w[2] = cvtpk((xv[8 * k + 4] - mu) * rstd * g1.x * bflo(gv[2]), (xv[8 * k + 5] - mu) * rstd * g1.y * bfhi(gv[2]));
      w[3] = cvtpk((xv[8 * k + 6] - mu) * rstd * g1.z * bflo(gv[3]), (xv[8 * k + 7] - mu) * rstd * g1.w * bfhi(gv[3]));
      *(u32x4*)(dst + 8 * k) = w;
    }
  }
  __syncthreads();
}

__device__ __forceinline__ void phase_attn(const Params& p, int l, char* smem) {
  for (int it = blockIdx.x; it < 256; it += gridDim.x) attn_diff_item(p, l, (it & 7) * 32 + (it >> 3), smem);
  for (int it = blockIdx.x; it < 512; it += gridDim.x) {
    const int r = it >> 8, c = it & 255, xcd = c & 7, j = c >> 3, pair = xcd & 3, qhl = (xcd >> 2) * 2 + r;
    attn_gqa_item(p, l, (((pair >> 1) * 8 + (pair & 1) * 4 + qhl) << 5) + j, smem);
  }
  for (int it = blockIdx.x; it < 512; it += gridDim.x) ret_r3_item(p, l, it, smem);
}


#define XB_TMO      128
#define XB_XCNT(j)  (256  + 64 * (j))
#define XB_XSUB(j)  (1280 + 64 * (j))
#define XB_XGEN(j)  (2304 + 64 * (j))
#define XB_TOP      3328
#define XB_TOPGEN   3392
#define XCD_BAR_WORDS 3456
#define XB_SPIN_CAP (1u << 20)
__device__ __forceinline__ unsigned xb_ld(unsigned* p)              { return __hip_atomic_load(p, __ATOMIC_RELAXED, __HIP_MEMORY_SCOPE_AGENT); }
__device__ __forceinline__ unsigned xb_add(unsigned* p, unsigned v) { return __hip_atomic_fetch_add(p, v, __ATOMIC_RELAXED, __HIP_MEMORY_SCOPE_AGENT); }
__device__ __forceinline__ unsigned xb_xcc_id() { return (unsigned)__builtin_amdgcn_s_getreg((3 << 11) | 20) & 0xFu; }
#define XB_SPIN(cond, bar) do { unsigned _sp = 0; while (cond) { __builtin_amdgcn_s_sleep(1); \
    if ((++_sp & 255u) == 0u) { if (xb_ld(&(bar)[XB_TMO])) break; if (_sp > XB_SPIN_CAP) { atomicAdd(&(bar)[XB_TMO], 1u); break; } } } } while (0)
struct XcdBarrier { unsigned* bar; unsigned x; };
#define XB_ST ((volatile unsigned*)(smem_all + LDS_BYTES))
__device__ __forceinline__ XcdBarrier xcd_barrier_post(unsigned* bar) {
  XcdBarrier b; b.bar = bar; b.x = xb_xcc_id();
  if (__builtin_amdgcn_workitem_id_x() == 0) (void)xb_add(&bar[XB_XCNT(b.x)], 1u);
  return b;
}
__device__ __forceinline__ void xcd_barrier_complete(unsigned* bar, unsigned x, unsigned& nloc, unsigned& nx) {
  const unsigned G = gridDim.x;
  unsigned sum, cnt, mine, sp = 0u;
  for (;;) {
    sum = 0u; cnt = 0u; mine = 0u;
#pragma unroll
    for (unsigned j = 0; j < 16; ++j) { const unsigned c = xb_ld(&bar[XB_XCNT(j)]); sum += c; cnt += (c > 0u) ? 1u : 0u; mine = (j == x) ? c : mine; }
    if (sum == G) break;
    __builtin_amdgcn_s_sleep(1);
    if ((++sp & 255u) == 0u) { if (xb_ld(&bar[XB_TMO])) break; if (sp > XB_SPIN_CAP) { atomicAdd(&bar[XB_TMO], 1u); break; } }
  }
  nloc = mine > 0u ? mine : 1u; nx = cnt > 0u ? cnt : 1u;
}
__device__ __forceinline__ void xcd_barrier(const XcdBarrier& b) {
  asm volatile("s_waitcnt vmcnt(0)" ::: "memory");
  __syncthreads();
  if (__builtin_amdgcn_workitem_id_x() == 0) {
    unsigned* bar = b.bar;
    __builtin_amdgcn_s_waitcnt(0);
    unsigned nloc = XB_ST[0], nx = XB_ST[1];
    if (nloc == 0u) { xcd_barrier_complete(bar, b.x, nloc, nx); XB_ST[0] = nloc; XB_ST[1] = nx; }
    const unsigned old = xb_add(&bar[XB_XSUB(b.x)], 1u);
    const unsigned gen = old / nloc;
    if (old + 1u == (gen + 1u) * nloc) {
      __builtin_amdgcn_fence(__ATOMIC_RELEASE, "agent");
      asm volatile("s_waitcnt vmcnt(0)" ::: "memory");
      const unsigned og = xb_add(&bar[XB_TOP], 1u);
      const unsigned tg = og / nx;
      if (og + 1u == (tg + 1u) * nx) xb_add(&bar[XB_TOPGEN], 1u);
      else XB_SPIN(xb_ld(&bar[XB_TOPGEN]) == tg, bar);
      __builtin_amdgcn_fence(__ATOMIC_ACQUIRE, "agent");
      xb_add(&bar[XB_XGEN(b.x)], 1u);
      asm volatile("s_waitcnt vmcnt(0)" ::: "memory");
    } else {
      XB_SPIN(xb_ld(&bar[XB_XGEN(b.x)]) == gen, bar);
      __builtin_amdgcn_fence(__ATOMIC_ACQUIRE, "agent");
      asm volatile("s_waitcnt vmcnt(0)" ::: "memory");
    }
  }
  __syncthreads();
}

__global__ void __launch_bounds__(NTHREADS) mega(Params p) {
  extern __shared__ __attribute__((aligned(16))) char smem[];
  cg::grid_group grid = cg::this_grid();
  volatile unsigned* xst = (volatile unsigned*)(smem + LDS_BYTES);
  if (__builtin_amdgcn_workitem_id_x() == 0) { xst[0] = 0u; xst[1] = 0u; xst[2] = 0u; xst[3] = 0u; }
  __syncthreads();
  XcdBarrier xb = xcd_barrier_post((unsigned*)(p.ws + OFF_BAR));
  for (int l = 0; l < 2; ++l) {
    const float* hin = (l == 0) ? p.x : p.out;
#pragma unroll 1
    for (int step = 0; step < 21; ++step) {
      bool do_resid = false; long r_wt = 0; size_t r_act = 0; int r_K = 1024, r_ld = LDU, r_tok0 = 0; const float* r_h = hin;
      if (step == 0) {
        if (l == 0) { phase_smallparams(p); phase_tables(p); }
        phase_wconv(p, l, smem);
      } else if (step < 15) {
        const int half = (step - 1) / 7, k = (step - 1) % 7;
        if (k == 0) phase_norm(p, hin, half * TH, (SPF(p) + SP_ATTN_NORM) + l * D);
        else if (k == 1) phase_gemm1(p, l, smem);
        else if (k == 2) phase_r1(p, l, smem);
        else if (k == 3) phase_r2(p, l);
        else if (k == 4) phase_attn(p, l, smem);
        else if (k == 5) phase_branch(p, smem);
        else { do_resid = true; r_wt = WT_OUT; r_act = OFF_MERGED; r_K = 1024; r_ld = LDU; r_h = hin; r_tok0 = half * TH; }
      } else {
        const int mh = (step - 15) / 3, k = (step - 15) % 3;
        if (k == 0) phase_norm(p, p.out, mh * TH, (SPF(p) + SP_MLPN) + l * D);
        else if (k == 1) phase_mlp1(p, smem);
        else { do_resid = true; r_wt = WT_W2; r_act = OFF_M; r_K = 4096; r_ld = LDM; r_h = p.out; r_tok0 = mh * TH; }
      }
      if (do_resid) phase_gemm_resid(p, r_wt, r_act, r_K, r_ld, r_h, r_tok0, smem);
      if (p.x == nullptr) grid.sync();
      else xcd_barrier(xb);
    }
  }
}

extern "C" void kernel_launch(void* const* d_in, const int* in_sizes, int n_in, void* d_out, int out_size, void* d_ws,
                              size_t ws_size, hipStream_t stream) {
  Params p{};
  p.x = (const float*)d_in[0]; p.attn_norm = (const float*)d_in[1]; p.w_in = (const float*)d_in[2];
  p.dqn = (const float*)d_in[3]; p.dkn = (const float*)d_in[4]; p.lq1 = (const float*)d_in[5]; p.lk1 = (const float*)d_in[6];
  p.lq2 = (const float*)d_in[7]; p.lk2 = (const float*)d_in[8]; p.subln = (const float*)d_in[9]; p.rdf = (const float*)d_in[10];
  p.rdb = (const float*)d_in[11]; p.rgn = (const float*)d_in[12]; p.gqn = (const float*)d_in[13]; p.gkn = (const float*)d_in[14];
  p.w_branch = (const float*)d_in[15]; p.w_out = (const float*)d_in[16]; p.mlp_norm = (const float*)d_in[17];
  p.w1 = (const float*)d_in[18]; p.w2 = (const float*)d_in[19];
  p.out = (float*)d_out; p.ws = (char*)d_ws;
  static int grid_blocks = 0;
  if (!grid_blocks) {
    if (hipFuncSetAttribute((const void*)mega, hipFuncAttributeMaxDynamicSharedMemorySize, LDS_ALLOC) != hipSuccess) {
      fprintf(stderr, "kernel_launch: hipFuncSetAttribute failed\n");
    }
    int dev = 0, cus = 0, per_cu = 0;
    (void)hipGetDevice(&dev);
    (void)hipDeviceGetAttribute(&cus, hipDeviceAttributeMultiprocessorCount, dev);
    (void)hipOccupancyMaxActiveBlocksPerMultiprocessor(&per_cu, (const void*)mega, NTHREADS, LDS_ALLOC);
    if (per_cu < 1) per_cu = 1;
    if (per_cu > 1) per_cu = 1;
    grid_blocks = cus * per_cu;
  }
  (void)hipMemsetAsync((char*)d_ws + OFF_BAR, 0, XCD_BAR_WORDS * 4, stream);
  void* args[] = {&p};
  hipError_t e = hipLaunchCooperativeKernel((const void*)mega, dim3(grid_blocks), dim3(NTHREADS), args, LDS_ALLOC, stream);
  if (e != hipSuccess) fprintf(stderr, "cooperative launch failed: %s (grid %d)\n", hipGetErrorString(e), grid_blocks);
}
```

```cpp
#include <hip/hip_runtime.h>
#include <hip/hip_cooperative_groups.h>
#include <cstdio>
#include <cstdint>
namespace cg = cooperative_groups;

typedef unsigned short u16;
typedef __attribute__((ext_vector_type(8))) short bf16x8;
typedef __attribute__((ext_vector_type(16))) float f32x16;
typedef __attribute__((ext_vector_type(4))) unsigned u32x4;
typedef __attribute__((ext_vector_type(2))) unsigned u32x2;
typedef float f32x4 __attribute__((ext_vector_type(4)));

constexpr int D = 1024, NBATCH = 4, S = 8192, T = NBATCH * S;
constexpr int TH = T / 2;
constexpr int INC = 7424, DFF = 4096;
constexpr int NTHREADS = 512;
constexpr int LDS_BYTES = 147456;
constexpr int LDS_ALLOC = LDS_BYTES + 16;

constexpr size_t MiB = 1ull << 20;
constexpr size_t OFF_U = 0, OFF_DQ = 36 * MiB, OFF_DK = 52 * MiB, OFF_DVT = 68 * MiB, OFF_RQ = 84 * MiB,
                 OFF_RK = 100 * MiB, OFF_RKT = 116 * MiB, OFF_RVT = 132 * MiB, OFF_RG = 148 * MiB, OFF_GQ = 164 * MiB,
                 OFF_GK = 180 * MiB, OFF_GVT = 184 * MiB, OFF_GATES = 188 * MiB, OFF_KVF = 284 * MiB,
                 OFF_KVB = 316 * MiB, OFF_ABUF = 348 * MiB, OFF_WT = 402 * MiB, OFF_TAB = 440 * MiB, OFF_BAR = 446 * MiB, OFF_SP = 447 * MiB;
constexpr int SP_ATTN_NORM = 0, SP_DQN = 2048, SP_DKN = 2176, SP_LQ1 = 2304, SP_LK1 = 2432, SP_LQ2 = 2560, SP_LK2 = 2688,
              SP_SUBLN = 2816, SP_RDF = 3072, SP_RDB = 3080, SP_RGN = 3088, SP_GQN = 4112, SP_GKN = 4240, SP_MLPN = 4368;
#define SPF(p) ((const float*)((p).ws + OFF_SP))
constexpr size_t OFF_MERGED = OFF_DQ, OFF_M = OFF_DQ;
constexpr int LDU = 1088, LDB3 = 576, LDM = 4160;
constexpr long WT_IN = 0, WT_BR = WT_IN + 7424l * LDU, WT_OUT = WT_BR + 3l * 1024 * LDB3, WT_W1 = WT_OUT + 1024l * LDU, WT_W2 = WT_W1 + 4096l * LDU;
constexpr long WT_BR_STRIDE = 1024l * LDB3;
constexpr int TAB_PT = 0, TAB_RT = 65536, TAB_AX = 65536 + 524288, TAB_N = 65536 + 524288 + 2048;

extern __shared__ __attribute__((aligned(16))) char smem_all[];

struct Params {
  const float *x, *attn_norm, *w_in, *dqn, *dkn, *lq1, *lk1, *lq2, *lk2, *subln, *rdf, *rdb, *rgn, *gqn, *gkn,
      *w_branch, *w_out, *mlp_norm, *w1, *w2;
  float* out;
  char* ws;
};

__device__ __forceinline__ int TIDX() { int t = __builtin_amdgcn_workitem_id_x(); asm volatile("" : "+v"(t)); return t; }
__device__ __forceinline__ unsigned cvtpk(float lo, float hi) {
  unsigned r;
  asm("v_cvt_pk_bf16_f32 %0, %1, %2" : "=v"(r) : "v"(lo), "v"(hi));
  return r;
}
__device__ __forceinline__ u16 f2bf(float x) { return (u16)(cvtpk(x, x) & 0xffffu); }
__device__ __forceinline__ float bf2f(u16 v) { return __uint_as_float(((unsigned)v) << 16); }
__device__ __forceinline__ float bflo(unsigned w) { return __uint_as_float(w << 16); }
__device__ __forceinline__ float bfhi(unsigned w) { return __uint_as_float(w & 0xffff0000u); }
__device__ __forceinline__ int crow(int r, int hi) { return (r & 3) + 8 * (r >> 2) + 4 * hi; }
__device__ __forceinline__ float xhalf_sum(float v) {
  auto rr = __builtin_amdgcn_permlane32_swap(__float_as_uint(v), __float_as_uint(v), false, false);
  return __uint_as_float(rr[0]) + __uint_as_float(rr[1]);
}
__device__ __forceinline__ float xhalf_max(float v) {
  auto rr = __builtin_amdgcn_permlane32_swap(__float_as_uint(v), __float_as_uint(v), false, false);
  return fmaxf(__uint_as_float(rr[0]), __uint_as_float(rr[1]));
}
__device__ __forceinline__ float shx(float v, int lane, int m) {
  return __int_as_float(__builtin_amdgcn_ds_bpermute(((lane ^ m) << 2), __float_as_int(v)));
}
__device__ __forceinline__ f32x16 mfma32(bf16x8 a, bf16x8 b, f32x16 c) {
  return __builtin_amdgcn_mfma_f32_32x32x16_bf16(a, b, c, 0, 0, 0);
}
__device__ __forceinline__ u32x2 pack4(float a, float b, float c, float d) {
  u32x2 r; r[0] = cvtpk(a, b); r[1] = cvtpk(c, d); return r;
}

__device__ __forceinline__ void phase_smallparams(const Params& p) {
  if (blockIdx.x != 0) return;
  float* sp = (float*)(p.ws + OFF_SP);
  const int t = TIDX();
  for (int i = t; i < 2048; i += NTHREADS) { sp[SP_ATTN_NORM + i] = p.attn_norm[i]; sp[SP_MLPN + i] = p.mlp_norm[i]; }
  for (int i = t; i < 1024; i += NTHREADS) sp[SP_RGN + i] = p.rgn[i];
  if (t < 256) sp[SP_SUBLN + t] = p.subln[t];
  if (t < 128) { sp[SP_DQN + t] = p.dqn[t]; sp[SP_DKN + t] = p.dkn[t]; sp[SP_LQ1 + t] = p.lq1[t]; sp[SP_LK1 + t] = p.lk1[t];
                 sp[SP_LQ2 + t] = p.lq2[t]; sp[SP_LK2 + t] = p.lk2[t]; sp[SP_GQN + t] = p.gqn[t]; sp[SP_GKN + t] = p.gkn[t]; }
  if (t < 8) { sp[SP_RDF + t] = p.rdf[t]; sp[SP_RDB + t] = p.rdb[t]; }
}

__device__ __forceinline__ void phase_tables(const Params& p) {
  float2* tab = (float2*)(p.ws + OFF_TAB);
  const int nth = gridDim.x * NTHREADS;
  for (int idx = blockIdx.x * NTHREADS + TIDX(); idx < TAB_N; idx += nth) {
    float pos, inv;
    if (idx < TAB_RT) { int s = idx >> 3, i = idx & 7; pos = (float)s; inv = powf(500000.0f, -(float)(2 * i) / 16.0f); }
    else if (idx < TAB_AX) { int k = idx - TAB_RT; int s = k >> 6, i = k & 63; pos = (float)s; inv = powf(10000.0f, -(float)(2 * i) / 128.0f); }
    else { int k = idx - TAB_AX; int s = k >> 4, i = k & 15; pos = (float)s; inv = powf(10000.0f, -(float)(2 * i) / 32.0f); }
    float ang = pos * inv;
    float sn, cs;
    sincosf(ang, &sn, &cs);
    tab[idx] = make_float2(cs, sn);
  }
}

__device__ __forceinline__ int phys_nat(int f);
__device__ __forceinline__ int phys_win(int f);
__device__ __forceinline__ void phase_wconv(const Params& p, int l, char* smem) {
  float* tl = (float*)smem;
  u16* wt = (u16*)(p.ws + OFF_WT);
  const int tid = TIDX();
  for (int t = blockIdx.x; t < 4544; t += gridDim.x) {
    const float* src; u16* dst; int K, N, tt, ldd, kind;
    if (t < 1856) { src = p.w_in + (long)l * D * INC; dst = wt + WT_IN; K = 1024; N = INC; tt = t; ldd = LDU; kind = 2; }
    else if (t < 2240) { int q = t - 1856; int nb = q >> 7; src = p.w_branch + ((long)l * 3 + nb) * 512 * 1024; dst = wt + WT_BR + (long)nb * WT_BR_STRIDE; K = 512; N = 1024; tt = q & 127; ldd = LDB3; kind = 1; }
    else if (t < 2496) { src = p.w_out + (long)l * D * D; dst = wt + WT_OUT; K = 1024; N = 1024; tt = t - 2240; ldd = LDU; kind = 1; }
    else if (t < 3520) { src = p.w1 + (long)l * D * DFF; dst = wt + WT_W1; K = 1024; N = DFF; tt = t - 2496; ldd = LDU; kind = 1; }
    else { src = p.w2 + (long)l * DFF * D; dst = wt + WT_W2; K = DFF; N = 1024; tt = t - 3520; ldd = LDM; kind = 1; }
    const int nkt = K >> 6;
    const int k0 = (tt % nkt) * 64, n0 = (tt / nkt) * 64;
#pragma unroll
    for (int i = 0; i < 2; ++i) {
      int k = (tid >> 4) + 32 * i, n4 = (tid & 15) * 4;
      float4 v = *(const float4*)(src + (long)(k0 + k) * N + n0 + n4);
      tl[(n4 + 0) * 65 + k] = v.x; tl[(n4 + 1) * 65 + k] = v.y; tl[(n4 + 2) * 65 + k] = v.z; tl[(n4 + 3) * 65 + k] = v.w;
    }
    __syncthreads();
    {
      int n = tid >> 3, kc = (tid & 7) * 8;
      const float* r = tl + n * 65 + kc;
      u32x4 w; w[0] = cvtpk(r[0], r[1]); w[1] = cvtpk(r[2], r[3]); w[2] = cvtpk(r[4], r[5]); w[3] = cvtpk(r[6], r[7]);
      const int nl = n0 + n; const int np = (kind == 2) ? phys_win(nl) : ((kind == 1) ? phys_nat(nl) : nl);
      *(u32x4*)(dst + (long)np * ldd + k0 + kc) = w;
    }
    __syncthreads();
  }
}

__device__ __forceinline__ void phase_norm(const Params& p, const float* hin, int tok0, const float* gain) {
  u16* u = (u16*)(p.ws + OFF_U);
  const int lane = TIDX() & 63;
  const int wv = blockIdx.x * 8 + (TIDX() >> 6), nwv = gridDim.x * 8;
  f32x4 g[4];
#pragma unroll
  for (int i = 0; i < 4; ++i) g[i] = *(const f32x4*)(gain + i * 256 + lane * 4);
  for (int t0 = wv * 4; t0 < TH; t0 += nwv * 4) {
    f32x4 v[4][4];
#pragma unroll
    for (int k = 0; k < 4; ++k)
#pragma unroll
      for (int i = 0; i < 4; ++i) v[k][i] = __builtin_nontemporal_load((const f32x4*)(hin + (long)(tok0 + t0 + k) * D + i * 256 + lane * 4));
#pragma unroll
    for (int k = 0; k < 4; ++k) {
      float ss = 0;
#pragma unroll
      for (int i = 0; i < 4; ++i) ss += v[k][i][0] * v[k][i][0] + v[k][i][1] * v[k][i][1] + v[k][i][2] * v[k][i][2] + v[k][i][3] * v[k][i][3];
#pragma unroll
      for (int o = 32; o >= 1; o >>= 1) ss += shx(ss, lane, o);
      const float rstd = rsqrtf(ss * (1.0f / D) + 1e-6f);
#pragma unroll
      for (int i = 0; i < 4; ++i) {
        const f32x4 y = v[k][i] * rstd * g[i];
        *(u32x2*)(u + (long)(t0 + k) * LDU + i * 256 + lane * 4) = pack4(y[0], y[1], y[2], y[3]);
      }
    }
  }
}

#define LAS __attribute__((address_space(3)))
constexpr int PBK = 64, PHALF = 128, HTB = PHALF * PBK * 2;
__device__ __forceinline__ int lds_byte(int r, int c) { const int st = (r >> 4) * 2 + (c >> 5), rr = r & 15, cc = c & 31, ob = rr * 64 + cc * 2; return st * 1024 + (ob ^ (((ob >> 9) & 1) << 5)); }
__device__ __forceinline__ void stage_rc(int b, int& R, int& C) { const int st = b / 1024, sb = b % 1024, swz = sb ^ (((sb >> 9) & 1) << 5); R = (st >> 1) * 16 + swz / 64; C = (st & 1) * 32 + (swz % 64) / 2; }
struct Unit { int pm, pn, nb; };
struct GemmD { const u16* A; const u16* Bt; int K, ld; size_t a_bs, b_bs; };
struct Sched {
  int ntiles, G, c, nbr;
  __device__ __forceinline__ bool next(int i, Unit& u) const {
    const int q = i / nbr;
    const long t = (long)q * G + c; if (t >= ntiles) return false;
    u.nb = i - q * nbr; u.pm = (int)(t & 63); u.pn = (int)(t >> 6); return true;
  }
};

template <class Epi>
__device__ __forceinline__ void gemm_phase(LAS unsigned char* lds, const GemmD g, const Sched& S, const Epi& E) {
  const int tid = TIDX(), wid = __builtin_amdgcn_readfirstlane(tid >> 6), lane = tid & 63, wr = wid >> 2, wc = wid & 3, fr = lane & 15, fq = lane >> 4;
  const int nt = g.K / PBK;
  unsigned voffA[2];
#pragma unroll
  for (int i = 0; i < 2; ++i) { int R, C; stage_rc(tid * 16 + i * 8192, R, C); voffA[i] = (unsigned)(R * g.ld + C) * 2u; }
  const size_t kstep = (size_t)(PBK * 2);
  const size_t hstep = (size_t)PHALF * g.ld * 2;
  const size_t tstep = 2 * hstep;
  const unsigned ldsw = (unsigned)wid * 1024u;
  const int aoff = lds_byte(wr * 64 + fr, fq * 8), boff = lds_byte(wc * 32 + fr, fq * 8);
#define PG8_SA(b, h) (((b) * 2 + (h)) * HTB)
#define PG8_SB(b, h) ((4 + (b) * 2 + (h)) * HTB)
#define PG8_STAGE(bufoff, gbase) do { const char* _gb = (const char*)(gbase); asm volatile("" : "+s"(_gb)); _Pragma("unroll") for (int _i = 0; _i < 2; ++_i) \
    __builtin_amdgcn_global_load_lds((const unsigned*)(_gb + voffA[_i]), (LAS unsigned*)(lds + (bufoff) + ldsw + _i * 8192), 16, 0, 0); } while (0)
#define PG8_LDA(dst, b, h) do { _Pragma("unroll") for (int m = 0; m < 4; ++m) _Pragma("unroll") for (int k = 0; k < 2; ++k) dst[m][k] = *(const LAS bf16x8*)(lds + PG8_SA(b, h) + aoff + m * 2048 + k * 1024); } while (0)
#define PG8_LDB(dst, b, h) do { _Pragma("unroll") for (int n = 0; n < 2; ++n) _Pragma("unroll") for (int k = 0; k < 2; ++k) dst[n][k] = *(const LAS bf16x8*)(lds + PG8_SB(b, h) + boff + n * 2048 + k * 1024); } while (0)
#define PG8_MMA(ai, bj, At, Bt) do { __builtin_amdgcn_s_setprio(1); _Pragma("unroll") for (int m = 0; m < 4; ++m) _Pragma("unroll") for (int n = 0; n < 2; ++n) _Pragma("unroll") for (int k = 0; k < 2; ++k) \
    acc[ai][bj][m][n] = __builtin_amdgcn_mfma_f32_16x16x32_bf16(Bt[n][k], At[m][k], acc[ai][bj][m][n], 0, 0, 0); __builtin_amdgcn_s_setprio(0); } while (0)
#define PG8_WAIT_V(n) asm volatile("s_waitcnt vmcnt(" #n ")" ::: "memory")
#define PG8_WAIT_L(n) asm volatile("s_waitcnt lgkmcnt(" #n ")" ::: "memory")
#define PG8_BAR __builtin_amdgcn_s_barrier()
#define PG8_SCHED __builtin_amdgcn_sched_barrier(0)
  Unit cur, nxt; int ui = 0;
  if (!S.next(0, cur)) return;
  f32x4 acc[2][2][4][2];
#pragma unroll
  for (int a = 0; a < 2; ++a)
#pragma unroll
    for (int b = 0; b < 2; ++b)
#pragma unroll
      for (int m = 0; m < 4; ++m)
#pragma unroll
        for (int n = 0; n < 2; ++n) acc[a][b][m][n] = (f32x4){0.f, 0.f, 0.f, 0.f};
  bf16x8 At[4][2], B0[2][2], B1[2][2];
  const char* cA = (const char*)g.A + (size_t)cur.pm * tstep + (size_t)cur.nb * g.a_bs; const char* cB = (const char*)g.Bt + (size_t)cur.pn * tstep + (size_t)cur.nb * g.b_bs;
  PG8_STAGE(PG8_SB(0, 0), cB); PG8_STAGE(PG8_SA(0, 0), cA); PG8_STAGE(PG8_SB(0, 1), cB + hstep); PG8_STAGE(PG8_SA(0, 1), cA + hstep);
  if (wr == 1) PG8_BAR;
  PG8_WAIT_V(4); PG8_BAR;
  PG8_STAGE(PG8_SB(1, 0), cB + kstep); PG8_STAGE(PG8_SA(1, 0), cA + kstep); PG8_STAGE(PG8_SB(1, 1), cB + hstep + kstep);
  PG8_WAIT_V(6); PG8_BAR;
  for (;;) {
    const bool has_next = S.next(ui + 1, nxt);
    const char* nA = has_next ? (const char*)g.A + (size_t)nxt.pm * tstep + (size_t)nxt.nb * g.a_bs : cA; const char* nB = has_next ? (const char*)g.Bt + (size_t)nxt.pn * tstep + (size_t)nxt.nb * g.b_bs : cB;
    for (int t = 0; t < nt; t += 2) {
      const bool last = (t == nt - 2);
      const char* a1 = cA + (size_t)(t + 1) * kstep;
      const char* a2 = last ? nA : cA + (size_t)(t + 2) * kstep; const char* b2 = last ? nB : cB + (size_t)(t + 2) * kstep;
      const char* a3 = a2 + kstep; const char* b3 = b2 + kstep;
      PG8_LDB(B0, 0, 0); PG8_SCHED; PG8_LDA(At, 0, 0); PG8_STAGE(PG8_SA(1, 1), a1 + hstep);
      PG8_WAIT_L(8); PG8_BAR; PG8_WAIT_L(0); PG8_MMA(0, 0, At, B0); PG8_BAR; PG8_SCHED;
      PG8_LDB(B1, 0, 1); PG8_STAGE(PG8_SB(0, 0), b2);
      PG8_BAR; PG8_WAIT_L(0); PG8_MMA(0, 1, At, B1); PG8_BAR;
      PG8_LDA(At, 0, 1); PG8_STAGE(PG8_SA(0, 0), a2);
      PG8_BAR; PG8_WAIT_L(0); PG8_MMA(1, 0, At, B0); PG8_BAR; PG8_SCHED;
      PG8_STAGE(PG8_SB(0, 1), b2 + hstep);
      PG8_WAIT_V(6); PG8_BAR; PG8_MMA(1, 1, At, B1); PG8_BAR;
      PG8_LDB(B0, 1, 0); PG8_SCHED; PG8_LDA(At, 1, 0); PG8_STAGE(PG8_SA(0, 1), a2 + hstep);
      PG8_WAIT_L(8); PG8_BAR; PG8_WAIT_L(0); PG8_MMA(0, 0, At, B0); PG8_BAR; PG8_SCHED;
      PG8_LDB(B1, 1, 1); PG8_STAGE(PG8_SB(1, 0), b3);
      PG8_BAR; PG8_WAIT_L(0); PG8_MMA(0, 1, At, B1); PG8_BAR;
      PG8_LDA(At, 1, 1); PG8_STAGE(PG8_SA(1, 0), a3);
      PG8_BAR; PG8_WAIT_L(0); PG8_MMA(1, 0, At, B0); PG8_BAR; PG8_SCHED;
      PG8_STAGE(PG8_SB(1, 1), b3 + hstep);
      PG8_WAIT_V(6); PG8_BAR; PG8_MMA(1, 1, At, B1); PG8_BAR;
    }
    E(acc, cur, wr, wc, fr, fq);
    if (!has_next) break;
    if (nxt.nb == 0)
#pragma unroll
    for (int a = 0; a < 2; ++a)
#pragma unroll
      for (int b = 0; b < 2; ++b)
#pragma unroll
        for (int m = 0; m < 4; ++m)
#pragma unroll
          for (int n = 0; n < 2; ++n) acc[a][b][m][n] = (f32x4){0.f, 0.f, 0.f, 0.f};
    cur = nxt; cA = nA; cB = nB; ++ui;
  }
  PG8_WAIT_V(0);
  if (wr == 0) PG8_BAR;
  PG8_BAR;
#undef PG8_SA
#undef PG8_SB
#undef PG8_STAGE
#undef PG8_LDA
#undef PG8_LDB
#undef PG8_MMA
#undef PG8_WAIT_V
#undef PG8_WAIT_L
#undef PG8_BAR
#undef PG8_SCHED
}

__device__ __forceinline__ int rho32(int d) { return ((d >> 2) & 1) * 16 + (d >> 3) * 4 + (d & 3); }
__device__ __forceinline__ int phys_nat(int f) { return (f & ~31) | rho32(f & 31); }
__device__ __forceinline__ int phys_g64(int f) { const int x = f & 255, wc = x >> 6, bj = (x >> 5) & 1; return (f & ~255) + bj * 128 + wc * 32 + rho32(x & 31); }
__device__ __forceinline__ int phys_h128(int f) { const int x = f & 255, hd = x >> 7, bj = (x >> 6) & 1, w1 = (x >> 5) & 1; return (f & ~255) + bj * 128 + (hd * 2 + w1) * 32 + rho32(x & 31); }
__device__ __forceinline__ int phys_win(int f) {
  if (f < 1024) return phys_g64(f);
  if (f < 1536) return phys_nat(f);
  if (f < 2560) return phys_h128(f);
  if (f < 3584) return phys_nat(f);
  if (f < 4352) return phys_g64(f);
  return phys_nat(f);
}

__device__ __forceinline__ u32x4 pack8(const f32x4& a, const f32x4& b) {
  u32x4 w; w[0] = cvtpk(a[0], a[1]); w[1] = cvtpk(a[2], a[3]); w[2] = cvtpk(b[0], b[1]); w[3] = cvtpk(b[2], b[3]); return w;
}

struct EpiResid {
  const float* hin; float* hout; int tok0;
  __device__ __forceinline__ void operator()(const f32x4 (&acc)[2][2][4][2], const Unit& u, int wr, int wc, int fr_, int fq_) const {
    const int ln_ = TIDX() & 63; const int fr = ln_ & 15, fq = ln_ >> 4; (void)fr_; (void)fq_;
#pragma unroll
    for (int ai = 0; ai < 2; ++ai)
#pragma unroll
      for (int m = 0; m < 4; ++m) {
        const long tg = (long)tok0 + u.pm * 256 + ai * 128 + wr * 64 + m * 16 + fr;
#pragma unroll
        for (int bj = 0; bj < 2; ++bj) {
          const int f0 = u.pn * 256 + bj * 128 + wc * 32 + 8 * fq;
          f32x4 h0 = __builtin_nontemporal_load((const f32x4*)(hin + tg * D + f0)), h1 = __builtin_nontemporal_load((const f32x4*)(hin + tg * D + f0 + 4));
          __builtin_nontemporal_store(h0 + acc[ai][bj][m][0], (f32x4*)(hout + tg * D + f0));
          __builtin_nontemporal_store(h1 + acc[ai][bj][m][1], (f32x4*)(hout + tg * D + f0 + 4));
        }
      }
  }
};

struct EpiRelu2 {
  u16* mb;
  __device__ __forceinline__ void operator()(const f32x4 (&acc)[2][2][4][2], const Unit& u, int wr, int wc, int fr_, int fq_) const {
    const int ln_ = TIDX() & 63; const int fr = ln_ & 15, fq = ln_ >> 4; (void)fr_; (void)fq_;
#pragma unroll
    for (int ai = 0; ai < 2; ++ai)
#pragma unroll
      for (int m = 0; m < 4; ++m) {
        const long tl = (long)u.pm * 256 + ai * 128 + wr * 64 + m * 16 + fr;
#pragma unroll
        for (int bj = 0; bj < 2; ++bj) {
          f32x4 a = acc[ai][bj][m][0], b = acc[ai][bj][m][1];
#pragma unroll
          for (int j = 0; j < 4; ++j) { float x = fmaxf(a[j], 0.f), y = fmaxf(b[j], 0.f); a[j] = x * x; b[j] = y * y; }
          *(u32x4*)(mb + tl * LDM + u.pn * 256 + bj * 128 + wc * 32 + 8 * fq) = pack8(a, b);
        }
      }
  }
};

__device__ __forceinline__ void load_cs4(const float2* t, f32x4& c, f32x4& sn) {
  const f32x4 a = *(const f32x4*)t, b = *(const f32x4*)(t + 2);
  c[0] = a[0]; sn[0] = a[1]; c[1] = a[2]; sn[1] = a[3]; c[2] = b[0]; sn[2] = b[1]; c[3] = b[2]; sn[3] = b[3];
}
__device__ __forceinline__ void st16(char* base, unsigned off, float v) { *(u16*)(base + off) = f2bf(v); }
struct EpiInproj {
  char* ws; int l;
  __device__ __forceinline__ void operator()(const f32x4 (&acc)[2][2][4][2], const Unit& u, int wr, int wc, int fr_, int fq_) const {
    const int ln_ = TIDX() & 63; const int fr = ln_ & 15, fq = ln_ >> 4; (void)fr_; (void)fq_;
    const float2* tab = (const float2*)(ws + OFF_TAB);
    const float* spf = (const float*)(ws + OFF_SP);
    const int lane = fq * 16 + fr;
    const int pn = u.pn;
    const int tlb = u.pm * 256 + wr * 64 + fr;
    if (pn < 4 || (pn >= 14 && pn <= 16)) {
      const int f0 = pn * 256 + wc * 64;
      if (f0 >= 4224) {
        const int kvh = (f0 - 4224) >> 6;
#pragma unroll
        for (int ai = 0; ai < 2; ++ai)
#pragma unroll
          for (int m = 0; m < 4; ++m) {
            const int tl = tlb + ai * 128 + m * 16, s = tl & (S - 1), bl = tl >> 13;
            const unsigned o0 = (unsigned)(((bl * 2 + kvh) * 64 + 8 * fq) * S + s) * 2u;
#pragma unroll
            for (int bj = 0; bj < 2; ++bj)
#pragma unroll
              for (int n = 0; n < 2; ++n)
#pragma unroll
                for (int j = 0; j < 4; ++j) st16(ws + OFF_GVT, o0 + (unsigned)((bj * 32 + 4 * n + j) * S * 2), acc[ai][bj][m][n][j]);
          }
        return;
      }
      const float* gain; u16* dst; int ldd; bool axial; float qsc = 1.0f;
      if (f0 < 512) { gain = spf + SP_DQN + l * 64; dst = (u16*)(ws + OFF_DQ) + f0; ldd = 512; axial = false; qsc = 0.125f * 1.4426950408889634f; }
      else if (f0 < 1024) { gain = spf + SP_DKN + l * 64; dst = (u16*)(ws + OFF_DK) + (f0 - 512); ldd = 512; axial = false; }
      else if (f0 < 4096) { gain = spf + SP_GQN + l * 64; dst = (u16*)(ws + OFF_GQ) + (f0 - 3584); ldd = 512; axial = true; qsc = 0.125f * 1.4426950408889634f; }
      else { gain = spf + SP_GKN + l * 64; dst = (u16*)(ws + OFF_GK) + (f0 - 4096); ldd = 128; axial = true; }
      f32x4 g[2][2];
#pragma unroll
      for (int bj = 0; bj < 2; ++bj)
#pragma unroll
        for (int n = 0; n < 2; ++n) g[bj][n] = *(const f32x4*)(gain + bj * 32 + 8 * fq + 4 * n);
#pragma unroll
      for (int ai = 0; ai < 2; ++ai)
#pragma unroll
        for (int m = 0; m < 4; ++m) {
          const int tl = tlb + ai * 128 + m * 16, s = tl & (S - 1);
          float ss = 0.f;
#pragma unroll
          for (int bj = 0; bj < 2; ++bj)
#pragma unroll
            for (int n = 0; n < 2; ++n)
#pragma unroll
              for (int j = 0; j < 4; ++j) { const float v = acc[ai][bj][m][n][j]; ss += v * v; }
          ss += shx(ss, lane, 16); ss += shx(ss, lane, 32);
          const float rstd = rsqrtf(ss * (1.0f / 64.0f) + 1e-6f);
          f32x4 y[2][2];
#pragma unroll
          for (int bj = 0; bj < 2; ++bj)
#pragma unroll
            for (int n = 0; n < 2; ++n) y[bj][n] = acc[ai][bj][m][n] * rstd * g[bj][n];
          if (!axial) {
#pragma unroll
            for (int n = 0; n < 2; ++n) {
              f32x4 cc, sn; load_cs4(tab + TAB_PT + s * 8 + 4 * n, cc, sn);
#pragma unroll
              for (int j = 0; j < 4; ++j) {
                const float own = y[0][n][j], oth = shx(own, lane, 16);
                const float r0 = own * cc[j] - oth * sn[j], r1 = own * cc[j] + oth * sn[j];
                y[0][n][j] = (fq == 0) ? r0 : ((fq == 1) ? r1 : own);
              }
            }
          } else {
#pragma unroll
            for (int bj = 0; bj < 2; ++bj)
#pragma unroll
              for (int n = 0; n < 2; ++n) {
                const int pos = (bj == 0) ? (s >> 6) : (s & 63);
                f32x4 cc, sn; load_cs4(tab + TAB_AX + pos * 16 + 8 * (fq & 1) + 4 * n, cc, sn);
#pragma unroll
                for (int j = 0; j < 4; ++j) {
                  const float own = y[bj][n][j], oth = shx(own, lane, 32);
                  y[bj][n][j] = (fq < 2) ? (own * cc[j] - oth * sn[j]) : (own * cc[j] + oth * sn[j]);
                }
              }
          }
#pragma unroll
          for (int bj = 0; bj < 2; ++bj) *(u32x4*)(dst + (long)tl * ldd + bj * 32 + 8 * fq) = pack8(y[bj][0] * qsc, y[bj][1] * qsc);
          __builtin_amdgcn_sched_barrier(0);
        }
    } else if (pn >= 6 && pn < 10) {
      const bool isk = (pn >= 8);
      const int hh = (pn - (isk ? 8 : 6)) * 2 + (wc >> 1), w1 = wc & 1;
      const float sc = isk ? 0.08838834764831845f : 1.0f;
      u16* dstn = (u16*)(ws + (isk ? OFF_RK : OFF_RQ)) + hh * 128 + w1 * 32 + 8 * fq;
#pragma unroll
      for (int ai = 0; ai < 2; ++ai)
#pragma unroll
        for (int m = 0; m < 4; ++m) {
          const int tl = tlb + ai * 128 + m * 16, s = tl & (S - 1), bl = tl >> 13;
          f32x4 y[2][2];
#pragma unroll
          for (int n = 0; n < 2; ++n) {
            f32x4 cc, sn; load_cs4(tab + TAB_RT + s * 64 + w1 * 32 + 8 * fq + 4 * n, cc, sn);
#pragma unroll
            for (int j = 0; j < 4; ++j) {
              const float x1 = acc[ai][0][m][n][j], x2 = acc[ai][1][m][n][j];
              y[0][n][j] = (x1 * cc[j] - x2 * sn[j]) * sc; y[1][n][j] = (x2 * cc[j] + x1 * sn[j]) * sc;
            }
          }
#pragma unroll
          for (int bj = 0; bj < 2; ++bj) *(u32x4*)(dstn + (long)tl * 512 + bj * 64) = pack8(y[bj][0], y[bj][1]);
          if (isk) {
            const unsigned o0 = (unsigned)(((bl * 4 + hh) * 128 + w1 * 32 + 8 * fq) * S + s) * 2u;
#pragma unroll
            for (int bj = 0; bj < 2; ++bj)
#pragma unroll
              for (int n = 0; n < 2; ++n)
#pragma unroll
                for (int j = 0; j < 4; ++j) st16(ws + OFF_RKT, o0 + (unsigned)((bj * 64 + 4 * n + j) * S * 2), y[bj][n][j]);
          }
          __builtin_amdgcn_sched_barrier(0);
        }
    } else if (pn == 4 || pn == 5 || pn == 10 || pn == 11) {
      const bool isd = (pn < 6);
      const int fbase = isd ? 1024 : 2560;
#pragma unroll
      for (int ai = 0; ai < 2; ++ai)
#pragma unroll
        for (int m = 0; m < 4; ++m) {
          const int tl = tlb + ai * 128 + m * 16, s = tl & (S - 1), bl = tl >> 13;
#pragma unroll
          for (int bj = 0; bj < 2; ++bj) {
            const int fl = pn * 256 + bj * 128 + wc * 32 + 8 * fq - fbase;
            const unsigned o0 = (unsigned)((bl * 4 * 128 + fl) * S + s) * 2u;
#pragma unroll
            for (int n = 0; n < 2; ++n)
#pragma unroll
              for (int j = 0; j < 4; ++j) st16(ws + (isd ? OFF_DVT : OFF_RVT), o0 + (unsigned)((4 * n + j) * S * 2), acc[ai][bj][m][n][j]);
          }
        }
    } else if (pn == 12 || pn == 13) {
#pragma unroll
      for (int ai = 0; ai < 2; ++ai)
#pragma unroll
        for (int m = 0; m < 4; ++m) {
          const long tl = tlb + ai * 128 + m * 16;
#pragma unroll
          for (int bj = 0; bj < 2; ++bj) {
            f32x4 a = acc[ai][bj][m][0], b = acc[ai][bj][m][1];
#pragma unroll
            for (int j = 0; j < 4; ++j) { a[j] = a[j] * __builtin_amdgcn_rcpf(1.0f + __expf(-a[j])); b[j] = b[j] * __builtin_amdgcn_rcpf(1.0f + __expf(-b[j])); }
            *(u32x4*)((u16*)(ws + OFF_RG) + tl * 512 + (pn - 12) * 256 + bj * 128 + wc * 32 + 8 * fq) = pack8(a, b);
          }
        }
    } else {
#pragma unroll
      for (int ai = 0; ai < 2; ++ai)
#pragma unroll
        for (int m = 0; m < 4; ++m) {
          const long tl = tlb + ai * 128 + m * 16;
#pragma unroll
          for (int bj = 0; bj < 2; ++bj) {
            f32x4 a = acc[ai][bj][m][0], b = acc[ai][bj][m][1];
            u32x2 w8; w8[0] = 0u; w8[1] = 0u;
#pragma unroll
            for (int j = 0; j < 4; ++j) {
              const unsigned qa = max((unsigned)fmaf(__builtin_amdgcn_rcpf(1.0f + __expf(-a[j])), 255.0f, 0.5f), 1u);
              const unsigned qb = max((unsigned)fmaf(__builtin_amdgcn_rcpf(1.0f + __expf(-b[j])), 255.0f, 0.5f), 1u);
              w8[0] |= qa << (8 * j); w8[1] |= qb << (8 * j);
            }
            *(u32x2*)((unsigned char*)(ws + OFF_GATES) + tl * 3072 + (pn - 17) * 256 + bj * 128 + wc * 32 + 8 * fq) = w8;
          }
        }
    }
  }
};

__device__ __forceinline__ void phase_gemm1(const Params& p, int l, char* smem) {
  GemmD g; g.A = (const u16*)(p.ws + OFF_U); g.Bt = (const u16*)(p.ws + OFF_WT) + WT_IN; g.K = 1024; g.ld = LDU; g.a_bs = 0; g.b_bs = 0;
  Sched sc; sc.ntiles = 29 * 64; sc.G = gridDim.x; sc.c = blockIdx.x; sc.nbr = 1;
  EpiInproj e; e.ws = p.ws; e.l = l;
  gemm_phase(( LAS unsigned char*)smem_all, g, sc, e);
}
__device__ __forceinline__ void phase_gemm_resid(const Params& p, long wt_off, size_t act_off, int K, int ld, const float* hin, int tok0, char* smem) {
  GemmD g; g.A = (const u16*)(p.ws + act_off); g.Bt = (const u16*)(p.ws + OFF_WT) + wt_off; g.K = K; g.ld = ld; g.a_bs = 0; g.b_bs = 0;
  Sched sc; sc.ntiles = 4 * 64; sc.G = gridDim.x; sc.c = blockIdx.x; sc.nbr = 1;
  EpiResid e; e.hin = hin; e.hout = p.out; e.tok0 = tok0;
  gemm_phase((LAS unsigned char*)smem_all, g, sc, e);
}
__device__ __forceinline__ void phase_mlp1(const Params& p, char* smem) {
  GemmD g; g.A = (const u16*)(p.ws + OFF_U); g.Bt = (const u16*)(p.ws + OFF_WT) + WT_W1; g.K = 1024; g.ld = LDU; g.a_bs = 0; g.b_bs = 0;
  Sched sc; sc.ntiles = 16 * 64; sc.G = gridDim.x; sc.c = blockIdx.x; sc.nbr = 1;
  EpiRelu2 e; e.mb = (u16*)(p.ws + OFF_M);
  gemm_phase((LAS unsigned char*)smem_all, g, sc, e);
}

struct EpiBranch {
  const unsigned char* gates; u16* merged;
  __device__ __forceinline__ void operator()(f32x4 (&acc)[2][2][4][2], const Unit& u, int wr, int wc, int fr_, int fq_) const {
    const int ln_ = TIDX() & 63; const int fr = ln_ & 15, fq = ln_ >> 4; (void)fr_; (void)fq_;
#pragma unroll
    for (int ai = 0; ai < 2; ++ai)
#pragma unroll
      for (int m = 0; m < 4; ++m) {
        const long tl = (long)u.pm * 256 + ai * 128 + wr * 64 + m * 16 + fr;
#pragma unroll
        for (int bj = 0; bj < 2; ++bj) {
          const int f0 = u.pn * 256 + bj * 128 + wc * 32 + 8 * fq;
          const unsigned char* gp = gates + tl * 3072 + f0 + u.nb * 1024;
          const u32x2 gn = *(const u32x2*)gp;
          float sc[8];
#pragma unroll
          for (int i = 0; i < 8; ++i) sc[i] = (float)((gn[i >> 2] >> (8 * (i & 3))) & 255u);
          if (u.nb < 2) {
            const u32x2 gx = *(const u32x2*)(gp + 1024);
#pragma unroll
            for (int i = 0; i < 8; ++i) sc[i] *= __builtin_amdgcn_rcpf((float)((gx[i >> 2] >> (8 * (i & 3))) & 255u));
          } else {
#pragma unroll
            for (int i = 0; i < 8; ++i) sc[i] *= (1.0f / 255.0f);
          }
#pragma unroll
          for (int j = 0; j < 4; ++j) { acc[ai][bj][m][0][j] *= sc[j]; acc[ai][bj][m][1][j] *= sc[4 + j]; }
          if (u.nb == 2) *(u32x4*)(merged + tl * LDU + f0) = pack8(acc[ai][bj][m][0], acc[ai][bj][m][1]);
        }
      }
  }
};
__device__ __forceinline__ void phase_branch(const Params& p, char* smem) {
  GemmD g; g.A = (const u16*)(p.ws + OFF_ABUF); g.Bt = (const u16*)(p.ws + OFF_WT) + WT_BR; g.K = 512; g.ld = LDB3;
  g.a_bs = (size_t)TH * LDB3 * 2; g.b_bs = (size_t)WT_BR_STRIDE * 2;
  Sched sc; sc.ntiles = 4 * 64; sc.G = gridDim.x; sc.c = blockIdx.x; sc.nbr = 3;
  EpiBranch e; e.gates = (const unsigned char*)(p.ws + OFF_GATES); e.merged = (u16*)(p.ws + OFF_MERGED);
  gemm_phase((LAS unsigned char*)smem_all, g, sc, e);
}

constexpr int AKT = 64 * 72, AVT = 128 * 72;
constexpr int ATT_STASH_OFF = 2 * (AKT + AVT) * 2;

__device__ __forceinline__ void qk_tile(f32x16& p0, f32x16& p1, const u16* kb, const bf16x8 (&qf)[4], int prow, int hi) {
  p0 = f32x16{}; p1 = f32x16{};
#pragma unroll
  for (int ds = 0; ds < 4; ++ds) {
    bf16x8 k0 = *(const bf16x8*)(kb + prow * 72 + ds * 16 + hi * 8);
    bf16x8 k1 = *(const bf16x8*)(kb + (32 + prow) * 72 + ds * 16 + hi * 8);
    p0 = mfma32(k0, qf[ds], p0);
    p1 = mfma32(k1, qf[ds], p1);
  }
}

template <int DV, bool PIPE, int MODE>
__device__ __forceinline__ void flash_loop(f32x16 (&o)[DV / 32], float& l_run, const u16* __restrict__ qrow,
                                           const u16* __restrict__ kbase, int ldk, const u16* __restrict__ vtbase, u16* lds) {
  constexpr int NDV = DV / 32;
  constexpr float C = (MODE == 0) ? 0.125f * 1.4426950408889634f : 1.0f;
  constexpr float THR = 8.0f / C;
  u16* kl = lds;
  u16* vl = lds + 2 * AKT;
  const int tid = TIDX(), lane = tid & 63, r32 = lane & 31, hi = lane >> 5;
  bf16x8 qf[4];
#pragma unroll
  for (int ds = 0; ds < 4; ++ds) qf[ds] = *(const bf16x8*)(qrow + ds * 16 + hi * 8);
  const int srow = tid >> 3, sc = (tid & 7) * 8;
  const unsigned kofs = (unsigned)(srow * ldk + sc) * 2u, vofs = (unsigned)(srow * S + sc) * 2u;
#define KG(j) ((const char*)(kbase + (long)(j) * 64 * ldk) + kofs)
#define VG(j) ((const char*)(vtbase + (long)(j) * 64) + vofs)
#define VG2(j) ((const char*)(vtbase + 64l * S + (long)(j) * 64) + vofs)
  bf16x8 kr, vr0, vr1;
  const int prow = (r32 & ~12) | ((r32 & 4) << 1) | ((r32 & 8) >> 1);
  float m_run = -1e30f;
  l_run = 0.0f;
#pragma unroll
  for (int d = 0; d < NDV; ++d) o[d] = f32x16{};
  constexpr int NT = S / 64;
  {
    bf16x8 k0 = *(const bf16x8*)KG(0), k1;
    if (PIPE) k1 = *(const bf16x8*)KG(1);
    vr0 = *(const bf16x8*)VG(0);
    if (DV == 128) vr1 = *(const bf16x8*)VG2(0);
    *(bf16x8*)(kl + srow * 72 + sc) = k0;
    if (PIPE) *(bf16x8*)(kl + AKT + srow * 72 + sc) = k1;
    *(bf16x8*)(vl + srow * 72 + sc) = vr0;
    if (DV == 128) *(bf16x8*)(vl + (64 + srow) * 72 + sc) = vr1;
  }
  __syncthreads();
  f32x16 pA0, pA1, pB0, pB1;
  if (PIPE) {
    qk_tile(pA0, pA1, kl, qf, prow, hi);
    asm volatile("s_waitcnt lgkmcnt(0)" ::: "memory"); __builtin_amdgcn_s_barrier(); asm volatile("" ::: "memory");
  }
#define FL_QKBLOCK(D0, D1)                                                                                       \
      f32x16 q0 = f32x16{}, q1 = f32x16{};                                                                       \
      _Pragma("unroll") for (int ds = 0; ds < 4; ++ds) { q0 = mfma32(kf[2 * ds], qf[ds], q0); q1 = mfma32(kf[2 * ds + 1], qf[ds], q1); } \
      D0 = q0; D1 = q1;
#define FL_BODY(PC0, PC1, PN0, PN1, J)                                                                           \
  {                                                                                                              \
    const int j_ = (J);                                                                                          \
    if (PIPE) { if (j_ + 2 < NT) kr = *(const bf16x8*)KG(j_ + 2); } else { if (j_ + 1 < NT) kr = *(const bf16x8*)KG(j_ + 1); } \
    if (j_ + 1 < NT) {                                                                                           \
      vr0 = *(const bf16x8*)VG(j_ + 1);                                                                          \
      if (DV == 128) vr1 = *(const bf16x8*)VG2(j_ + 1);                                                          \
    }                                                                                                            \
    const u16* kb = kl + ((PIPE ? (j_ + 1) : j_) & 1) * AKT;                                                     \
    const u16* vb = vl + (j_ & 1) * AVT;                                                                         \
    bf16x8 kf[8], vf[2][NDV];                                                                                    \
    _Pragma("unroll") for (int ds = 0; ds < 4; ++ds) {                                                           \
      kf[2 * ds] = *(const bf16x8*)(kb + prow * 72 + ds * 16 + hi * 8);                                          \
      kf[2 * ds + 1] = *(const bf16x8*)(kb + (32 + prow) * 72 + ds * 16 + hi * 8);                               \
    }                                                                                                            \
    _Pragma("unroll") for (int d = 0; d < NDV; ++d) vf[0][d] = *(const bf16x8*)(vb + (d * 32 + r32) * 72 + hi * 8);  \
    __builtin_amdgcn_sched_barrier(0);                                                                           \
    if (!PIPE) { FL_QKBLOCK(PC0, PC1) }                                                                          \
    if (PIPE && DV != 64) { if (j_ + 1 < NT) { FL_QKBLOCK(PN0, PN1) } }                                          \
    float ps = 0.0f;                                                                                             \
    if (MODE == 2) {                                                                                             \
      _Pragma("unroll") for (int r = 0; r < 16; ++r) { PC0[r] = __builtin_amdgcn_exp2f(PC0[r]); ps += PC0[r]; }  \
      _Pragma("unroll") for (int r = 0; r < 16; ++r) { PC1[r] = __builtin_amdgcn_exp2f(PC1[r]); ps += PC1[r]; }  \
    } else {                                                                                                     \
    float mx = PC0[0];                                                                                           \
    _Pragma("unroll") for (int r = 1; r < 16; ++r) mx = fmaxf(mx, PC0[r]);                                       \
    _Pragma("unroll") for (int r = 0; r < 16; ++r) mx = fmaxf(mx, PC1[r]);                                       \
    mx = xhalf_max(mx);                                                                                          \
    if (!__all(mx - m_run <= THR)) {                                                                             \
      const float mn = fmaxf(m_run, mx);                                                                         \
      const float alpha = __builtin_amdgcn_exp2f((m_run - mn) * C);                                              \
      m_run = mn;                                                                                                \
      l_run *= alpha;                                                                                            \
      _Pragma("unroll") for (int d = 0; d < NDV; ++d)                                                            \
        _Pragma("unroll") for (int r = 0; r < 16; ++r) o[d][r] *= alpha;                                         \
    }                                                                                                            \
    const float mnC = -m_run * C;                                                                                \
    _Pragma("unroll") for (int r = 0; r < 16; ++r) { PC0[r] = __builtin_amdgcn_exp2f(fmaf(PC0[r], C, mnC)); ps += PC0[r]; } \
    _Pragma("unroll") for (int r = 0; r < 16; ++r) { PC1[r] = __builtin_amdgcn_exp2f(fmaf(PC1[r], C, mnC)); ps += PC1[r]; } \
    }                                                                                                            \
    if (MODE != 2) ps = xhalf_sum(ps);        \
    l_run += ps;                                                                                                 \
    bf16x8 pb[4];                                                                                                \
    {                                                                                                            \
      u32x4 w;                                                                                                   \
      w[0] = cvtpk(PC0[0], PC0[1]); w[1] = cvtpk(PC0[2], PC0[3]); w[2] = cvtpk(PC0[4], PC0[5]); w[3] = cvtpk(PC0[6], PC0[7]);       \
      pb[0] = *reinterpret_cast<bf16x8*>(&w);                                                                    \
      w[0] = cvtpk(PC0[8], PC0[9]); w[1] = cvtpk(PC0[10], PC0[11]); w[2] = cvtpk(PC0[12], PC0[13]); w[3] = cvtpk(PC0[14], PC0[15]); \
      pb[1] = *reinterpret_cast<bf16x8*>(&w);                                                                    \
      w[0] = cvtpk(PC1[0], PC1[1]); w[1] = cvtpk(PC1[2], PC1[3]); w[2] = cvtpk(PC1[4], PC1[5]); w[3] = cvtpk(PC1[6], PC1[7]);       \
      pb[2] = *reinterpret_cast<bf16x8*>(&w);                                                                    \
      w[0] = cvtpk(PC1[8], PC1[9]); w[1] = cvtpk(PC1[10], PC1[11]); w[2] = cvtpk(PC1[12], PC1[13]); w[3] = cvtpk(PC1[14], PC1[15]); \
      pb[3] = *reinterpret_cast<bf16x8*>(&w);                                                                    \
    }                                                                                                            \
    __builtin_amdgcn_sched_barrier(0);                                                                           \
    if (PIPE && DV == 64) { if (j_ + 1 < NT) { FL_QKBLOCK(PN0, PN1) } }     \
    _Pragma("unroll") for (int kk = 0; kk < 4; ++kk) {                                                           \
      if (kk + 1 < 4) {                                                                                          \
        _Pragma("unroll") for (int d = 0; d < NDV; ++d)                                                          \
          vf[(kk + 1) & 1][d] = *(const bf16x8*)(vb + (d * 32 + r32) * 72 + (kk + 1) * 16 + hi * 8);            \
      }                                                                                                          \
      __builtin_amdgcn_sched_barrier(0);                                                                         \
      _Pragma("unroll") for (int d = 0; d < NDV; ++d) o[d] = mfma32(vf[kk & 1][d], pb[kk], o[d]);                \
      __builtin_amdgcn_sched_barrier(0);                                                                         \
    }                                                                                                            \
    if (PIPE) { if (j_ + 2 < NT) *(bf16x8*)(kl + (j_ & 1) * AKT + srow * 72 + sc) = kr; } else { if (j_ + 1 < NT) *(bf16x8*)(kl + ((j_ + 1) & 1) * AKT + srow * 72 + sc) = kr; } \
    if (j_ + 1 < NT) {                                                                                           \
      const int b_ = (j_ + 1) & 1;                                                                               \
      *(bf16x8*)(vl + b_ * AVT + srow * 72 + sc) = vr0;                                                          \
      if (DV == 128) *(bf16x8*)(vl + b_ * AVT + (64 + srow) * 72 + sc) = vr1;                                    \
    }                                                                                                            \
    __syncthreads();                                                                                             \
  }
  for (int j = 0; j < NT; j += 2) {
    FL_BODY(pA0, pA1, pB0, pB1, j)
    FL_BODY(pB0, pB1, pA0, pA1, j + 1)
  }
#undef FL_BODY
#undef FL_QKBLOCK
  if (MODE == 2) l_run = xhalf_sum(l_run);
#undef KG
#undef VG
#undef VG2
}

__device__ __forceinline__ void attn_diff_item(const Params& p, int l, int item, char* smem) {
  const int qt = item & 31, hh = (item >> 5) & 3, bl = item >> 7;
  const int tid = TIDX(), lane = tid & 63, wid = tid >> 6, r32 = lane & 31, hi = lane >> 5;
#define ATT_TL() (bl * S + qt * 256 + (TIDX() >> 6) * 32 + (TIDX() & 31))
  const u16* dq = (const u16*)(p.ws + OFF_DQ);
  const u16* dk = (const u16*)(p.ws + OFF_DK);
  const u16* dvt = (const u16*)(p.ws + OFF_DVT) + ((long)(bl * 4 + hh) * 128) * S;
  unsigned* stash = (unsigned*)(smem + ATT_STASH_OFF) + wid * 2048;
  f32x16 o[4]; float lr;
  float bq = 0.f, bk = 0.f;
  for (int i = 0; i < 64; ++i) { bq = fmaxf(bq, fabsf((SPF(p) + SP_DQN)[l * 64 + i])); bk = fmaxf(bk, fabsf((SPF(p) + SP_DKN)[l * 64 + i])); }
  const bool small = (8.0f * bq * bk < 40.0f);
  if (small) flash_loop<128, true, 2>(o, lr, dq + (long)ATT_TL() * 512 + (hh * 2) * 64, dk + (long)(bl * S) * 512 + (hh * 2) * 64, 512, dvt, (u16*)smem);
  else flash_loop<128, false, 1>(o, lr, dq + (long)ATT_TL() * 512 + (hh * 2) * 64, dk + (long)(bl * S) * 512 + (hh * 2) * 64, 512, dvt, (u16*)smem);
  {
    const float inv = 1.0f / lr;
#pragma unroll
    for (int d = 0; d < 4; ++d)
#pragma unroll
      for (int pr = 0; pr < 8; ++pr) stash[(d * 8 + pr) * 64 + lane] = cvtpk(o[d][2 * pr] * inv, o[d][2 * pr + 1] * inv);
  }
  if (small) flash_loop<128, true, 2>(o, lr, dq + (long)ATT_TL() * 512 + (hh * 2 + 1) * 64, dk + (long)(bl * S) * 512 + (hh * 2 + 1) * 64, 512, dvt, (u16*)smem);
  else flash_loop<128, false, 1>(o, lr, dq + (long)ATT_TL() * 512 + (hh * 2 + 1) * 64, dk + (long)(bl * S) * 512 + (hh * 2 + 1) * 64, 512, dvt, (u16*)smem);
  float s1 = 0, s2 = 0;
  for (int i = 0; i < 64; ++i) { s1 += (SPF(p) + SP_LQ1)[l * 64 + i] * (SPF(p) + SP_LK1)[l * 64 + i]; s2 += (SPF(p) + SP_LQ2)[l * 64 + i] * (SPF(p) + SP_LK2)[l * 64 + i]; }
  int ll = l; asm volatile("" : "+s"(ll));
  const float lambda_init = (ll == 0) ? 0.2f : (0.8f - 0.6f * 0.7408182206817179f);
  const float lam = expf(s1) - expf(s2) + lambda_init;
  const float inv2 = lam / lr;
  float ss = 0;
#pragma unroll
  for (int d = 0; d < 4; ++d)
#pragma unroll
    for (int pr = 0; pr < 8; ++pr) {
      unsigned w = stash[(d * 8 + pr) * 64 + lane];
      float a0 = bflo(w) - inv2 * o[d][2 * pr], a1 = bfhi(w) - inv2 * o[d][2 * pr + 1];
      o[d][2 * pr] = a0; o[d][2 * pr + 1] = a1; ss += a0 * a0 + a1 * a1;
    }
  ss = xhalf_sum(ss);
  const float rstd = rsqrtf(ss * (1.0f / 128.0f) + 1e-5f) * (1.0f - lambda_init);
  const float* sg = (SPF(p) + SP_SUBLN) + l * 128;
  u16* dst = (u16*)(p.ws + OFF_ABUF) + (long)ATT_TL() * LDB3 + hh * 128;
#pragma unroll
  for (int d = 0; d < 4; ++d)
#pragma unroll
    for (int q4 = 0; q4 < 4; ++q4) {
      const int dv0 = d * 32 + 8 * q4 + 4 * hi;
      float4 g = *(const float4*)(sg + dv0);
      *(u32x2*)(dst + dv0) = pack4(o[d][4 * q4] * rstd * g.x, o[d][4 * q4 + 1] * rstd * g.y, o[d][4 * q4 + 2] * rstd * g.z, o[d][4 * q4 + 3] * rstd * g.w);
    }
}
#undef ATT_TL

__device__ __forceinline__ void attn_gqa_item(const Params& p, int l, int item, char* smem) {
  const int qt = item & 31, qh = (item >> 5) & 7, bl = item >> 8;
  const int tid = TIDX(), lane = tid & 63, wid = tid >> 6, r32 = lane & 31, hi = lane >> 5;
  const int tl = bl * S + qt * 256 + wid * 32 + r32;
  const int kvh = qh >> 2;
  const u16* gq = (const u16*)(p.ws + OFF_GQ);
  const u16* gk = (const u16*)(p.ws + OFF_GK);
  const u16* gvt = (const u16*)(p.ws + OFF_GVT) + ((long)(bl * 2 + kvh) * 64) * S;
  f32x16 o[2]; float lr;
  float bq = 0.f, bk = 0.f;
  for (int i = 0; i < 64; ++i) { bq = fmaxf(bq, fabsf((SPF(p) + SP_GQN)[l * 64 + i])); bk = fmaxf(bk, fabsf((SPF(p) + SP_GKN)[l * 64 + i])); }
  if (8.0f * bq * bk < 40.0f)
    flash_loop<64, true, 2>(o, lr, gq + (long)tl * 512 + qh * 64, gk + (long)(bl * S) * 128 + kvh * 64, 128, gvt, (u16*)smem);
  else
    flash_loop<64, true, 1>(o, lr, gq + (long)tl * 512 + qh * 64, gk + (long)(bl * S) * 128 + kvh * 64, 128, gvt, (u16*)smem);
  const float inv = 1.0f / lr;
  u16* dst = (u16*)(p.ws + OFF_ABUF) + 2l * TH * LDB3 + (long)tl * LDB3 + qh * 64;
#pragma unroll
  for (int d = 0; d < 2; ++d)
#pragma unroll
    for (int q4 = 0; q4 < 4; ++q4)
      *(u32x2*)(dst + d * 32 + 8 * q4 + 4 * hi) = pack4(o[d][4 * q4] * inv, o[d][4 * q4 + 1] * inv, o[d][4 * q4 + 2] * inv, o[d][4 * q4 + 3] * inv);
}

constexpr int RROW = 136;
constexpr int RBUF = 128 * RROW;

__device__ __forceinline__ void mm128(f32x16 (&acc)[2], const u16* Al, const u16* Bl) {
  const int lane = TIDX() & 63, wid = TIDX() >> 6, r32 = lane & 31, hi = lane >> 5;
  const int wm = wid >> 2, wn = wid & 3;
#pragma unroll
  for (int ks = 0; ks < 8; ++ks) {
    bf16x8 bfr = *(const bf16x8*)(Bl + (wn * 32 + r32) * RROW + ks * 16 + hi * 8);
#pragma unroll
    for (int mt = 0; mt < 2; ++mt) {
      bf16x8 af = *(const bf16x8*)(Al + (wm * 64 + mt * 32 + r32) * RROW + ks * 16 + hi * 8);
      acc[mt] = mfma32(af, bfr, acc[mt]);
    }
  }
}

__device__ __forceinline__ void stage128(u16* dstl, const u16* src, long ld) {
  const int row = TIDX() >> 2, c = (TIDX() & 3) * 32;
  const u16* s = src + (long)row * ld + c;
  bf16x8 v0 = *(const bf16x8*)s, v1 = *(const bf16x8*)(s + 8), v2 = *(const bf16x8*)(s + 16), v3 = *(const bf16x8*)(s + 24);
  u16* d = dstl + row * RROW + c;
  *(bf16x8*)d = v0; *(bf16x8*)(d + 8) = v1; *(bf16x8*)(d + 16) = v2; *(bf16x8*)(d + 24) = v3;
}
__device__ __forceinline__ void stage128_f32(u16* dstl, const float* src) {
  const int row = TIDX() >> 2, c = (TIDX() & 3) * 32;
  const float* s = src + row * 128 + c;
  u16* d = dstl + row * RROW + c;
#pragma unroll
  for (int i = 0; i < 4; ++i) {
    float4 a = *(const float4*)(s + 8 * i), b = *(const float4*)(s + 8 * i + 4);
    u32x4 w; w[0] = cvtpk(a.x, a.y); w[1] = cvtpk(a.z, a.w); w[2] = cvtpk(b.x, b.y); w[3] = cvtpk(b.z, b.w);
    *(u32x4*)(d + 8 * i) = w;
  }
}

__device__ __forceinline__ void phase_r1(const Params& p, int l, char* smem) {
  u16* B0 = (u16*)smem;
  u16* B1 = B0 + RBUF;
  u16* B2 = B1 + RBUF;
  float* zf = (float*)(smem + 3 * RBUF * 2);
  float* zb = zf + 128;
  const int tid = TIDX(), lane = tid & 63, wid = tid >> 6, r32 = lane & 31, hi = lane >> 5;
  const int wm = wid >> 2, wn = wid & 3;
  for (int item = blockIdx.x; item < 512; item += gridDim.x) {
    const int n = item & 63, bh = item >> 6, hh = bh & 3;
    const float lf = -expf((SPF(p) + SP_RDF)[l * 4 + hh]), lb = -expf((SPF(p) + SP_RDB)[l * 4 + hh]);
    if (tid < 128) { zf[tid] = expf((float)(127 - tid) * lf); zb[tid] = expf((float)tid * lb); }
    const u16* vsrc = (const u16*)(p.ws + OFF_RVT) + ((long)bh * 128) * S + n * 128;
    const u16* ksrc = (const u16*)(p.ws + OFF_RKT) + ((long)bh * 128) * S + n * 128;
    stage128(B0, vsrc, S);
    __syncthreads();
    {
      const int row = tid >> 2, c = (tid & 3) * 32;
      const u16* s = ksrc + (long)row * S + c;
#pragma unroll
      for (int i = 0; i < 4; ++i) {
        u32x4 v = *(const u32x4*)(s + 8 * i);
        u32x4 wf_, wb_;
#pragma unroll
        for (int q = 0; q < 4; ++q) {
          const int j = c + 8 * i + 2 * q;
          float a = bflo(v[q]), b = bfhi(v[q]);
          wf_[q] = cvtpk(a * zf[j], b * zf[j + 1]);
          wb_[q] = cvtpk(a * zb[j], b * zb[j + 1]);
        }
        *(u32x4*)(B1 + row * RROW + c + 8 * i) = wf_;
        *(u32x4*)(B2 + row * RROW + c + 8 * i) = wb_;
      }
    }
    __syncthreads();
    f32x16 af[2], ab[2];
    af[0] = f32x16{}; af[1] = f32x16{}; ab[0] = f32x16{}; ab[1] = f32x16{};
    mm128(af, B0, B1);
    mm128(ab, B0, B2);
    u16* of = (u16*)(p.ws + OFF_KVF) + (long)item * 16384;
    u16* ob = (u16*)(p.ws + OFF_KVB) + (long)item * 16384;
#pragma unroll
    for (int mt = 0; mt < 2; ++mt)
#pragma unroll
      for (int r = 0; r < 16; ++r) {
        const int e = wm * 64 + mt * 32 + crow(r, hi), d = wn * 32 + r32;
        of[e * 128 + d] = f2bf(af[mt][r]);
        ob[e * 128 + d] = f2bf(ab[mt][r]);
      }
    __syncthreads();
  }
}

__device__ __forceinline__ void phase_r2(const Params& p, int l) {
  const int nth = gridDim.x * NTHREADS;
  for (int idx = blockIdx.x * NTHREADS + TIDX(); idx < 65536; idx += nth) {
    const int dir = idx >> 15, e4 = idx & 32767, bh = e4 >> 12, ed = (e4 & 4095) * 4, hh = bh & 3;
    u16* base = (u16*)(p.ws + (dir ? OFF_KVB : OFF_KVF)) + ((long)bh * 64) * 16384 + ed;
    const float lg = -expf((dir ? (SPF(p) + SP_RDB) : (SPF(p) + SP_RDF))[l * 4 + hh]);
    const float dec = expf(128.0f * lg);
    float s0 = 0.f, s1 = 0.f, s2 = 0.f, s3 = 0.f;
    for (int nb = 0; nb < 8; ++nb) {
      u32x2 t[8];
#pragma unroll
      for (int i = 0; i < 8; ++i) { int n = nb * 8 + i; if (dir) n = 63 - n; t[i] = *(const u32x2*)(base + (long)n * 16384); }
#pragma unroll
      for (int i = 0; i < 8; ++i) {
        int n = nb * 8 + i; if (dir) n = 63 - n;
        u32x2 w; w[0] = cvtpk(s0, s1); w[1] = cvtpk(s2, s3);
        *(u32x2*)(base + (long)n * 16384) = w;
        s0 = s0 * dec + bflo(t[i][0]); s1 = s1 * dec + bfhi(t[i][0]); s2 = s2 * dec + bflo(t[i][1]); s3 = s3 * dec + bfhi(t[i][1]);
      }
    }
  }
}

__device__ __forceinline__ void ret_r3_item(const Params& p, int l, int item, char* smem) {
  u16* B0 = (u16*)smem;
  u16* B1 = B0 + RBUF;
  u16* B2 = B1 + RBUF;
  u16* B3 = B2 + RBUF;
  float* OL = (float*)B1;
  const int tid = TIDX(), lane = tid & 63, wid = tid >> 6, r32 = lane & 31, hi = lane >> 5;
  const int wm = wid >> 2, wn = wid & 3;
  const int n = item & 63, bh = item >> 6, hh = bh & 3, bl = bh >> 2;
  const float lf = -expf((SPF(p) + SP_RDF)[l * 4 + hh]), lb = -expf((SPF(p) + SP_RDB)[l * 4 + hh]);
  const long tl0 = (long)bl * S + n * 128;
  stage128(B0, (const u16*)(p.ws + OFF_RQ) + tl0 * 512 + hh * 128, 512);
  stage128(B1, (const u16*)(p.ws + OFF_RK) + tl0 * 512 + hh * 128, 512);
  stage128(B2, (const u16*)(p.ws + OFF_RVT) + ((long)bh * 128) * S + n * 128, S);
  stage128(B3, (const u16*)(p.ws + OFF_KVF) + (long)item * 16384, 128);
  __syncthreads();
  f32x16 sc[2], cr[2], out[2];
  sc[0] = f32x16{}; sc[1] = f32x16{}; cr[0] = f32x16{}; cr[1] = f32x16{};
  mm128(sc, B0, B1);
  mm128(cr, B0, B3);
#pragma unroll
  for (int mt = 0; mt < 2; ++mt)
#pragma unroll
    for (int r = 0; r < 16; ++r) {
      const int i = wm * 64 + mt * 32 + crow(r, hi);
      out[mt][r] = __expf((float)(i + 1) * lf) * cr[mt][r];
    }
  __syncthreads();
#pragma unroll
  for (int mt = 0; mt < 2; ++mt)
#pragma unroll
    for (int r = 0; r < 16; ++r) {
      const int i = wm * 64 + mt * 32 + crow(r, hi), j = wn * 32 + r32;
      const float dd = (float)(i - j);
      const float dec = (i >= j) ? __expf(dd * lf) : __expf(-dd * lb);
      B1[i * RROW + j] = f2bf(sc[mt][r] * dec);
    }
  stage128(B3, (const u16*)(p.ws + OFF_KVB) + (long)item * 16384, 128);
  __syncthreads();
  cr[0] = f32x16{}; cr[1] = f32x16{};
  mm128(out, B1, B2);
  mm128(cr, B0, B3);
#pragma unroll
  for (int mt = 0; mt < 2; ++mt)
#pragma unroll
    for (int r = 0; r < 16; ++r) {
      const int i = wm * 64 + mt * 32 + crow(r, hi);
      out[mt][r] += __expf((float)(128 - i) * lb) * cr[mt][r];
    }
  __syncthreads();
#pragma unroll
  for (int mt = 0; mt < 2; ++mt)
#pragma unroll
    for (int r = 0; r < 16; ++r) {
      const int i = wm * 64 + mt * 32 + crow(r, hi), e = wn * 32 + r32;
      OL[i * 132 + e] = out[mt][r];
    }
  __syncthreads();
  {
    const int i = tid >> 2, qd = tid & 3;
    float xv[32];
    float sm = 0;
#pragma unroll
    for (int k = 0; k < 8; ++k) {
      float4 v = *(const float4*)(OL + i * 132 + qd * 32 + 4 * k);
      xv[4 * k] = v.x; xv[4 * k + 1] = v.y; xv[4 * k + 2] = v.z; xv[4 * k + 3] = v.w;
      sm += v.x + v.y + v.z + v.w;
    }
    sm += shx(sm, lane, 1); sm += shx(sm, lane, 2);
    const float mu = sm * (1.0f / 128.0f);
    float vs = 0;
#pragma unroll
    for (int k = 0; k < 32; ++k) { float dlt = xv[k] - mu; vs += dlt * dlt; }
    vs += shx(vs, lane, 1); vs += shx(vs, lane, 2);
    const float rstd = rsqrtf(vs * (1.0f / 128.0f) + 1e-5f);
    const float* gn = (SPF(p) + SP_RGN) + l * 512 + hh * 128 + qd * 32;
    const u16* rg = (const u16*)(p.ws + OFF_RG) + (tl0 + i) * 512 + hh * 128 + qd * 32;
    u16* dst = (u16*)(p.ws + OFF_ABUF) + 1l * TH * LDB3 + (tl0 + i) * LDB3 + hh * 128 + qd * 32;
#pragma unroll
    for (int k = 0; k < 4; ++k) {
      u32x4 gv = *(const u32x4*)(rg + 8 * k);
      float4 g0 = *(const float4*)(gn + 8 * k), g1 = *(const float4*)(gn + 8 * k + 4);
      u32x4 w;
      w[0] = cvtpk((xv[8 * k + 0] - mu) * rstd * g0.x * bflo(gv[0]), (xv[8 * k + 1] - mu) * rstd * g0.y * bfhi(gv[0]));
      w[1] = cvtpk((xv[8 * k + 2] - mu) * rstd * g0.z * bflo(gv[1]), (xv[8 * k + 3] - mu) * rstd * g0.w * bfhi(gv[1]));
      w[2] = cvtpk((xv[8 * k + 4] - mu) * rstd * g1.x * bflo(gv[2]), (xv[8 * k + 5] - mu) * rstd * g1.y * bfhi(gv[2]));
      w[3] = cvtpk((xv[8 * k + 6] - mu) * rstd * g1.z * bflo(gv[3]), (xv[8 * k + 7] - mu) * rstd * g1.w * bfhi(gv[3]));
      *(u32x4*)(dst + 8 * k) = w;
    }
  }
  __syncthreads();
}

__device__ __forceinline__ void phase_attn(const Params& p, int l, char* smem) {
  for (int it = blockIdx.x; it < 256; it += gridDim.x) attn_diff_item(p, l, (it & 7) * 32 + (it >> 3), smem);
  for (int it = blockIdx.x; it < 512; it += gridDim.x) {
    const int r = it >> 8, c = it & 255, xcd = c & 7, j = c >> 3, pair = xcd & 3, qhl = (xcd >> 2) * 2 + r;
    attn_gqa_item(p, l, (((pair >> 1) * 8 + (pair & 1) * 4 + qhl) << 5) + j, smem);
  }
  for (int it = blockIdx.x; it < 512; it += gridDim.x) ret_r3_item(p, l, it, smem);
}


#define XB_TMO      128
#define XB_XCNT(j)  (256  + 64 * (j))
#define XB_XSUB(j)  (1280 + 64 * (j))
#define XB_XGEN(j)  (2304 + 64 * (j))
#define XB_TOP      3328
#define XB_TOPGEN   3392
#define XCD_BAR_WORDS 3456
#define XB_SPIN_CAP (1u << 20)
__device__ __forceinline__ unsigned xb_ld(unsigned* p)              { return __hip_atomic_load(p, __ATOMIC_RELAXED, __HIP_MEMORY_SCOPE_AGENT); }
__device__ __forceinline__ unsigned xb_add(unsigned* p, unsigned v) { return __hip_atomic_fetch_add(p, v, __ATOMIC_RELAXED, __HIP_MEMORY_SCOPE_AGENT); }
__device__ __forceinline__ unsigned xb_xcc_id() { return (unsigned)__builtin_amdgcn_s_getreg((3 << 11) | 20) & 0xFu; }
#define XB_SPIN(cond, bar) do { unsigned _sp = 0; while (cond) { __builtin_amdgcn_s_sleep(1); \
    if ((++_sp & 255u) == 0u) { if (xb_ld(&(bar)[XB_TMO])) break; if (_sp > XB_SPIN_CAP) { atomicAdd(&(bar)[XB_TMO], 1u); break; } } } } while (0)
struct XcdBarrier { unsigned* bar; unsigned x; };
#define XB_ST ((volatile unsigned*)(smem_all + LDS_BYTES))
__device__ __forceinline__ XcdBarrier xcd_barrier_post(unsigned* bar) {
  XcdBarrier b; b.bar = bar; b.x = xb_xcc_id();
  if (__builtin_amdgcn_workitem_id_x() == 0) (void)xb_add(&bar[XB_XCNT(b.x)], 1u);
  return b;
}
__device__ __forceinline__ void xcd_barrier_complete(unsigned* bar, unsigned x, unsigned& nloc, unsigned& nx) {
  const unsigned G = gridDim.x;
  unsigned sum, cnt, mine, sp = 0u;
  for (;;) {
    sum = 0u; cnt = 0u; mine = 0u;
#pragma unroll
    for (unsigned j = 0; j < 16; ++j) { const unsigned c = xb_ld(&bar[XB_XCNT(j)]); sum += c; cnt += (c > 0u) ? 1u : 0u; mine = (j == x) ? c : mine; }
    if (sum == G) break;
    __builtin_amdgcn_s_sleep(1);
    if ((++sp & 255u) == 0u) { if (xb_ld(&bar[XB_TMO])) break; if (sp > XB_SPIN_CAP) { atomicAdd(&bar[XB_TMO], 1u); break; } }
  }
  nloc = mine > 0u ? mine : 1u; nx = cnt > 0u ? cnt : 1u;
}
__device__ __forceinline__ void xcd_barrier(const XcdBarrier& b) {
  asm volatile("s_waitcnt vmcnt(0)" ::: "memory");
  __syncthreads();
  if (__builtin_amdgcn_workitem_id_x() == 0) {
    unsigned* bar = b.bar;
    __builtin_amdgcn_s_waitcnt(0);
    unsigned nloc = XB_ST[0], nx = XB_ST[1];
    if (nloc == 0u) { xcd_barrier_complete(bar, b.x, nloc, nx); XB_ST[0] = nloc; XB_ST[1] = nx; }
    const unsigned old = xb_add(&bar[XB_XSUB(b.x)], 1u);
    const unsigned gen = old / nloc;
    if (old + 1u == (gen + 1u) * nloc) {
      __builtin_amdgcn_fence(__ATOMIC_RELEASE, "agent");
      asm volatile("s_waitcnt vmcnt(0)" ::: "memory");
      const unsigned og = xb_add(&bar[XB_TOP], 1u);
      const unsigned tg = og / nx;
      if (og + 1u == (tg + 1u) * nx) xb_add(&bar[XB_TOPGEN], 1u);
      else XB_SPIN(xb_ld(&bar[XB_TOPGEN]) == tg, bar);
      __builtin_amdgcn_fence(__ATOMIC_ACQUIRE, "agent");
      xb_add(&bar[XB_XGEN(b.x)], 1u);
      asm volatile("s_waitcnt vmcnt(0)" ::: "memory");
    } else {
      XB_SPIN(xb_ld(&bar[XB_XGEN(b.x)]) == gen, bar);
      __builtin_amdgcn_fence(__ATOMIC_ACQUIRE, "agent");
      asm volatile("s_waitcnt vmcnt(0)" ::: "memory");
    }
  }
  __syncthreads();
}

__global__ void __launch_bounds__(NTHREADS) mega(Params p) {
  extern __shared__ __attribute__((aligned(16))) char smem[];
  cg::grid_group grid = cg::this_grid();
  volatile unsigned* xst = (volatile unsigned*)(smem + LDS_BYTES);
  if (__builtin_amdgcn_workitem_id_x() == 0) { xst[0] = 0u; xst[1] = 0u; xst[2] = 0u; xst[3] = 0u; }
  __syncthreads();
  XcdBarrier xb = xcd_barrier_post((unsigned*)(p.ws + OFF_BAR));
  for (int l = 0; l < 2; ++l) {
    const float* hin = (l == 0) ? p.x : p.out;
#pragma unroll 1
    for (int step = 0; step < 21; ++step) {
      bool do_resid = false; long r_wt = 0; size_t r_act = 0; int r_K = 1024, r_ld = LDU, r_tok0 = 0; const float* r_h = hin;
      if (step == 0) {
        if (l == 0) { phase_smallparams(p); phase_tables(p); }
        phase_wconv(p, l, smem);
      } else if (step < 15) {
        const int half = (step - 1) / 7, k = (step - 1) % 7;
        if (k == 0) phase_norm(p, hin, half * TH, (SPF(p) + SP_ATTN_NORM) + l * D);
        else if (k == 1) phase_gemm1(p, l, smem);
        else if (k == 2) phase_r1(p, l, smem);
        else if (k == 3) phase_r2(p, l);
        else if (k == 4) phase_attn(p, l, smem);
        else if (k == 5) phase_branch(p, smem);
        else { do_resid = true; r_wt = WT_OUT; r_act = OFF_MERGED; r_K = 1024; r_ld = LDU; r_h = hin; r_tok0 = half * TH; }
      } else {
        const int mh = (step - 15) / 3, k = (step - 15) % 3;
        if (k == 0) phase_norm(p, p.out, mh * TH, (SPF(p) + SP_MLPN) + l * D);
        else if (k == 1) phase_mlp1(p, smem);
        else { do_resid = true; r_wt = WT_W2; r_act = OFF_M; r_K = 4096; r_ld = LDM; r_h = p.out; r_tok0 = mh * TH; }
      }
      if (do_resid) phase_gemm_resid(p, r_wt, r_act, r_K, r_ld, r_h, r_tok0, smem);
      if (p.x == nullptr) grid.sync();
      else xcd_barrier(xb);
    }
  }
}

extern "C" void kernel_launch(void* const* d_in, const int* in_sizes, int n_in, void* d_out, int out_size, void* d_ws,
                              size_t ws_size, hipStream_t stream) {
  Params p{};
  p.x = (const float*)d_in[0]; p.attn_norm = (const float*)d_in[1]; p.w_in = (const float*)d_in[2];
  p.dqn = (const float*)d_in[3]; p.dkn = (const float*)d_in[4]; p.lq1 = (const float*)d_in[5]; p.lk1 = (const float*)d_in[6];
  p.lq2 = (const float*)d_in[7]; p.lk2 = (const float*)d_in[8]; p.subln = (const float*)d_in[9]; p.rdf = (const float*)d_in[10];
  p.rdb = (const float*)d_in[11]; p.rgn = (const float*)d_in[12]; p.gqn = (const float*)d_in[13]; p.gkn = (const float*)d_in[14];
  p.w_branch = (const float*)d_in[15]; p.w_out = (const float*)d_in[16]; p.mlp_norm = (const float*)d_in[17];
  p.w1 = (const float*)d_in[18]; p.w2 = (const float*)d_in[19];
  p.out = (float*)d_out; p.ws = (char*)d_ws;
  static int grid_blocks = 0;
  if (!grid_blocks) {
    if (hipFuncSetAttribute((const void*)mega, hipFuncAttributeMaxDynamicSharedMemorySize, LDS_ALLOC) != hipSuccess) {
      fprintf(stderr, "kernel_launch: hipFuncSetAttribute failed\n");
    }
    int dev = 0, cus = 0, per_cu = 0;
    (void)hipGetDevice(&dev);
    (void)hipDeviceGetAttribute(&cus, hipDeviceAttributeMultiprocessorCount, dev);
    (void)hipOccupancyMaxActiveBlocksPerMultiprocessor(&per_cu, (const void*)mega, NTHREADS, LDS_ALLOC);
    if (per_cu < 1) per_cu = 1;
    if (per_cu > 1) per_cu = 1;
    grid_blocks = cus * per_cu;
  }
  (void)hipMemsetAsync((char*)d_ws + OFF_BAR, 0, XCD_BAR_WORDS * 4, stream);
  void* args[] = {&p};
  hipError_t e = hipLaunchCooperativeKernel((const void*)mega, dim3(grid_blocks), dim3(NTHREADS), args, LDS_ALLOC, stream);
  if (e != hipSuccess) fprintf(stderr, "cooperative launch failed: %s (grid %d)\n", hipGetErrorString(e), grid_blocks);
}
```

```cpp
#include <hip/hip_runtime.h>
#include <hip/hip_cooperative_groups.h>
#include <cstdio>
#include <cstdint>
namespace cg = cooperative_groups;

typedef unsigned short u16;
typedef __attribute__((ext_vector_type(8))) short bf16x8;
typedef __attribute__((ext_vector_type(16))) float f32x16;
typedef __attribute__((ext_vector_type(4))) unsigned u32x4;
typedef __attribute__((ext_vector_type(2))) unsigned u32x2;
typedef float f32x4 __attribute__((ext_vector_type(4)));

constexpr int D = 1024, NBATCH = 4, S = 8192, T = NBATCH * S;
constexpr int TH = T / 2;
constexpr int INC = 7424, DFF = 4096;
constexpr int NTHREADS = 512;
constexpr int LDS_BYTES = 147456;
constexpr int LDS_ALLOC = LDS_BYTES + 16;

constexpr size_t MiB = 1ull << 20;
constexpr size_t OFF_U = 0, OFF_DQ = 36 * MiB, OFF_DK = 52 * MiB, OFF_DVT = 68 * MiB, OFF_RQ = 84 * MiB,
                 OFF_RK = 100 * MiB, OFF_RKT = 116 * MiB, OFF_RVT = 132 * MiB, OFF_RG = 148 * MiB, OFF_GQ = 164 * MiB,
                 OFF_GK = 180 * MiB, OFF_GVT = 184 * MiB, OFF_GATES = 188 * MiB, OFF_KVF = 284 * MiB,
                 OFF_KVB = 316 * MiB, OFF_ABUF = 348 * MiB, OFF_WT = 402 * MiB, OFF_TAB = 440 * MiB, OFF_BAR = 446 * MiB, OFF_SP = 447 * MiB;
constexpr int SP_ATTN_NORM = 0, SP_DQN = 2048, SP_DKN = 2176, SP_LQ1 = 2304, SP_LK1 = 2432, SP_LQ2 = 2560, SP_LK2 = 2688,
              SP_SUBLN = 2816, SP_RDF = 3072, SP_RDB = 3080, SP_RGN = 3088, SP_GQN = 4112, SP_GKN = 4240, SP_MLPN = 4368;
#define SPF(p) ((const float*)((p).ws + OFF_SP))
constexpr size_t OFF_MERGED = OFF_DQ, OFF_M = OFF_DQ;
constexpr int LDU = 1088, LDB3 = 576, LDM = 4160;
constexpr long WT_IN = 0, WT_BR = WT_IN + 7424l * LDU, WT_OUT = WT_BR + 3l * 1024 * LDB3, WT_W1 = WT_OUT + 1024l * LDU, WT_W2 = WT_W1 + 4096l * LDU;
constexpr long WT_BR_STRIDE = 1024l * LDB3;
constexpr int TAB_PT = 0, TAB_RT = 65536, TAB_AX = 65536 + 524288, TAB_N = 65536 + 524288 + 2048;

extern __shared__ __attribute__((aligned(16))) char smem_all[];

struct Params {
  const float *x, *attn_norm, *w_in, *dqn, *dkn, *lq1, *lk1, *lq2, *lk2, *subln, *rdf, *rdb, *rgn, *gqn, *gkn,
      *w_branch, *w_out, *mlp_norm, *w1, *w2;
  float* out;
  char* ws;
};

__device__ __forceinline__ int TIDX() { int t = __builtin_amdgcn_workitem_id_x(); asm volatile("" : "+v"(t)); return t; }
__device__ __forceinline__ unsigned cvtpk(float lo, float hi) {
  unsigned r;
  asm("v_cvt_pk_bf16_f32 %0, %1, %2" : "=v"(r) : "v"(lo), "v"(hi));
  return r;
}
__device__ __forceinline__ u16 f2bf(float x) { return (u16)(cvtpk(x, x) & 0xffffu); }
__device__ __forceinline__ float bf2f(u16 v) { return __uint_as_float(((unsigned)v) << 16); }
__device__ __forceinline__ float bflo(unsigned w) { return __uint_as_float(w << 16); }
__device__ __forceinline__ float bfhi(unsigned w) { return __uint_as_float(w & 0xffff0000u); }
__device__ __forceinline__ int crow(int r, int hi) { return (r & 3) + 8 * (r >> 2) + 4 * hi; }
__device__ __forceinline__ float xhalf_sum(float v) {
  auto rr = __builtin_amdgcn_permlane32_swap(__float_as_uint(v), __float_as_uint(v), false, false);
  return __uint_as_float(rr[0]) + __uint_as_float(rr[1]);
}
__device__ __forceinline__ float xhalf_max(float v) {
  auto rr = __builtin_amdgcn_permlane32_swap(__float_as_uint(v), __float_as_uint(v), false, false);
  return fmaxf(__uint_as_float(rr[0]), __uint_as_float(rr[1]));
}
__device__ __forceinline__ float shx(float v, int lane, int m) {
  return __int_as_float(__builtin_amdgcn_ds_bpermute(((lane ^ m) << 2), __float_as_int(v)));
}
__device__ __forceinline__ f32x16 mfma32(bf16x8 a, bf16x8 b, f32x16 c) {
  return __builtin_amdgcn_mfma_f32_32x32x16_bf16(a, b, c, 0, 0, 0);
}
__device__ __forceinline__ u32x2 pack4(float a, float b, float c, float d) {
  u32x2 r; r[0] = cvtpk(a, b); r[1] = cvtpk(c, d); return r;
}

__device__ __forceinline__ void phase_smallparams(const Params& p) {
  if (blockIdx.x != 0) return;
  float* sp = (float*)(p.ws + OFF_SP);
  const int t = TIDX();
  for (int i = t; i < 2048; i += NTHREADS) { sp[SP_ATTN_NORM + i] = p.attn_norm[i]; sp[SP_MLPN + i] = p.mlp_norm[i]; }
  for (int i = t; i < 1024; i += NTHREADS) sp[SP_RGN + i] = p.rgn[i];
  if (t < 256) sp[SP_SUBLN + t] = p.subln[t];
  if (t < 128) { sp[SP_DQN + t] = p.dqn[t]; sp[SP_DKN + t] = p.dkn[t]; sp[SP_LQ1 + t] = p.lq1[t]; sp[SP_LK1 + t] = p.lk1[t];
                 sp[SP_LQ2 + t] = p.lq2[t]; sp[SP_LK2 + t] = p.lk2[t]; sp[SP_GQN + t] = p.gqn[t]; sp[SP_GKN + t] = p.gkn[t]; }
  if (t < 8) { sp[SP_RDF + t] = p.rdf[t]; sp[SP_RDB + t] = p.rdb[t]; }
}

__device__ __forceinline__ void phase_tables(const Params& p) {
  float2* tab = (float2*)(p.ws + OFF_TAB);
  const int nth = gridDim.x * NTHREADS;
  for (int idx = blockIdx.x * NTHREADS + TIDX(); idx < TAB_N; idx += nth) {
    float pos, inv;
    if (idx < TAB_RT) { int s = idx >> 3, i = idx & 7; pos = (float)s; inv = powf(500000.0f, -(float)(2 * i) / 16.0f); }
    else if (idx < TAB_AX) { int k = idx - TAB_RT; int s = k >> 6, i = k & 63; pos = (float)s; inv = powf(10000.0f, -(float)(2 * i) / 128.0f); }
    else { int k = idx - TAB_AX; int s = k >> 4, i = k & 15; pos = (float)s; inv = powf(10000.0f, -(float)(2 * i) / 32.0f); }
    float ang = pos * inv;
    float sn, cs;
    sincosf(ang, &sn, &cs);
    tab[idx] = make_float2(cs, sn);
  }
}

__device__ __forceinline__ int phys_nat(int f);
__device__ __forceinline__ int phys_win(int f);
__device__ __forceinline__ void phase_wconv(const Params& p, int l, char* smem) {
  float* tl = (float*)smem;
  u16* wt = (u16*)(p.ws + OFF_WT);
  const int tid = TIDX();
  for (int t = blockIdx.x; t < 4544; t += gridDim.x) {
    const float* src; u16* dst; int K, N, tt, ldd, kind;
    if (t < 1856) { src = p.w_in + (long)l * D * INC; dst = wt + WT_IN; K = 1024; N = INC; tt = t; ldd = LDU; kind = 2; }
    else if (t < 2240) { int q = t - 1856; int nb = q >> 7; src = p.w_branch + ((long)l * 3 + nb) * 512 * 1024; dst = wt + WT_BR + (long)nb * WT_BR_STRIDE; K = 512; N = 1024; tt = q & 127; ldd = LDB3; kind = 1; }
    else if (t < 2496) { src = p.w_out + (long)l * D * D; dst = wt + WT_OUT; K = 1024; N = 1024; tt = t - 2240; ldd = LDU; kind = 1; }
    else if (t < 3520) { src = p.w1 + (long)l * D * DFF; dst = wt + WT_W1; K = 1024; N = DFF; tt = t - 2496; ldd = LDU; kind = 1; }
    else { src = p.w2 + (long)l * DFF * D; dst = wt + WT_W2; K = DFF; N = 1024; tt = t - 3520; ldd = LDM; kind = 1; }
    const int nkt = K >> 6;
    const int k0 = (tt % nkt) * 64, n0 = (tt / nkt) * 64;
#pragma unroll
    for (int i = 0; i < 2; ++i) {
      int k = (tid >> 4) + 32 * i, n4 = (tid & 15) * 4;
      float4 v = *(const float4*)(src + (long)(k0 + k) * N + n0 + n4);
      tl[(n4 + 0) * 65 + k] = v.x; tl[(n4 + 1) * 65 + k] = v.y; tl[(n4 + 2) * 65 + k] = v.z; tl[(n4 + 3) * 65 + k] = v.w;
    }
    __syncthreads();
    {
      int n = tid >> 3, kc = (tid & 7) * 8;
      const float* r = tl + n * 65 + kc;
      u32x4 w; w[0] = cvtpk(r[0], r[1]); w[1] = cvtpk(r[2], r[3]); w[2] = cvtpk(r[4], r[5]); w[3] = cvtpk(r[6], r[7]);
      const int nl = n0 + n; const int np = (kind == 2) ? phys_win(nl) : ((kind == 1) ? phys_nat(nl) : nl);
      *(u32x4*)(dst + (long)np * ldd + k0 + kc) = w;
    }
    __syncthreads();
  }
}

__device__ __forceinline__ void phase_norm(const Params& p, const float* hin, int tok0, const float* gain) {
  u16* u = (u16*)(p.ws + OFF_U);
  const int lane = TIDX() & 63;
  const int wv = blockIdx.x * 8 + (TIDX() >> 6), nwv = gridDim.x * 8;
  f32x4 g[4];
#pragma unroll
  for (int i = 0; i < 4; ++i) g[i] = *(const f32x4*)(gain + i * 256 + lane * 4);
  for (int t0 = wv * 4; t0 < TH; t0 += nwv * 4) {
    f32x4 v[4][4];
#pragma unroll
    for (int k = 0; k < 4; ++k)
#pragma unroll
      for (int i = 0; i < 4; ++i) v[k][i] = __builtin_nontemporal_load((const f32x4*)(hin + (long)(tok0 + t0 + k) * D + i * 256 + lane * 4));
#pragma unroll
    for (int k = 0; k < 4; ++k) {
      float ss = 0;
#pragma unroll
      for (int i = 0; i < 4; ++i) ss += v[k][i][0] * v[k][i][0] + v[k][i][1] * v[k][i][1] + v[k][i][2] * v[k][i][2] + v[k][i][3] * v[k][i][3];
#pragma unroll
      for (int o = 32; o >= 1; o >>= 1) ss += shx(ss, lane, o);
      const float rstd = rsqrtf(ss * (1.0f / D) + 1e-6f);
#pragma unroll
      for (int i = 0; i < 4; ++i) {
        const f32x4 y = v[k][i] * rstd * g[i];
        *(u32x2*)(u + (long)(t0 + k) * LDU + i * 256 + lane * 4) = pack4(y[0], y[1], y[2], y[3]);
      }
    }
  }
}

#define LAS __attribute__((address_space(3)))
constexpr int PBK = 64, PHALF = 128, HTB = PHALF * PBK * 2;
__device__ __forceinline__ int lds_byte(int r, int c) { const int st = (r >> 4) * 2 + (c >> 5), rr = r & 15, cc = c & 31, ob = rr * 64 + cc * 2; return st * 1024 + (ob ^ (((ob >> 9) & 1) << 5)); }
__device__ __forceinline__ void stage_rc(int b, int& R, int& C) { const int st = b / 1024, sb = b % 1024, swz = sb ^ (((sb >> 9) & 1) << 5); R = (st >> 1) * 16 + swz / 64; C = (st & 1) * 32 + (swz % 64) / 2; }
struct Unit { int pm, pn, nb; };
struct GemmD { const u16* A; const u16* Bt; int K, ld; size_t a_bs, b_bs; };
struct Sched {
  int ntiles, G, c, nbr;
  __device__ __forceinline__ bool next(int i, Unit& u) const {
    const int q = i / nbr;
    const long t = (long)q * G + c; if (t >= ntiles) return false;
    u.nb = i - q * nbr; u.pm = (int)(t & 63); u.pn = (int)(t >> 6); return true;
  }
};

template <class Epi>
__device__ __forceinline__ void gemm_phase(LAS unsigned char* lds, const GemmD g, const Sched& S, const Epi& E) {
  const int tid = TIDX(), wid = __builtin_amdgcn_readfirstlane(tid >> 6), lane = tid & 63, wr = wid >> 2, wc = wid & 3, fr = lane & 15, fq = lane >> 4;
  const int nt = g.K / PBK;
  unsigned voffA[2];
#pragma unroll
  for (int i = 0; i < 2; ++i) { int R, C; stage_rc(tid * 16 + i * 8192, R, C); voffA[i] = (unsigned)(R * g.ld + C) * 2u; }
  const size_t kstep = (size_t)(PBK * 2);
  const size_t hstep = (size_t)PHALF * g.ld * 2;
  const size_t tstep = 2 * hstep;
  const unsigned ldsw = (unsigned)wid * 1024u;
  const int aoff = lds_byte(wr * 64 + fr, fq * 8), boff = lds_byte(wc * 32 + fr, fq * 8);
#define PG8_SA(b, h) (((b) * 2 + (h)) * HTB)
#define PG8_SB(b, h) ((4 + (b) * 2 + (h)) * HTB)
#define PG8_STAGE(bufoff, gbase) do { const char* _gb = (const char*)(gbase); asm volatile("" : "+s"(_gb)); _Pragma("unroll") for (int _i = 0; _i < 2; ++_i) \
    __builtin_amdgcn_global_load_lds((const unsigned*)(_gb + voffA[_i]), (LAS unsigned*)(lds + (bufoff) + ldsw + _i * 8192), 16, 0, 0); } while (0)
#define PG8_LDA(dst, b, h) do { _Pragma("unroll") for (int m = 0; m < 4; ++m) _Pragma("unroll") for (int k = 0; k < 2; ++k) dst[m][k] = *(const LAS bf16x8*)(lds + PG8_SA(b, h) + aoff + m * 2048 + k * 1024); } while (0)
#define PG8_LDB(dst, b, h) do { _Pragma("unroll") for (int n = 0; n < 2; ++n) _Pragma("unroll") for (int k = 0; k < 2; ++k) dst[n][k] = *(const LAS bf16x8*)(lds + PG8_SB(b, h) + boff + n * 2048 + k * 1024); } while (0)
#define PG8_MMA(ai, bj, At, Bt) do { __builtin_amdgcn_s_setprio(1); _Pragma("unroll") for (int m = 0; m < 4; ++m) _Pragma("unroll") for (int n = 0; n < 2; ++n) _Pragma("unroll") for (int k = 0; k < 2; ++k) \
    acc[ai][bj][m][n] = __builtin_amdgcn_mfma_f32_16x16x32_bf16(Bt[n][k], At[m][k], acc[ai][bj][m][n], 0, 0, 0); __builtin_amdgcn_s_setprio(0); } while (0)
#define PG8_WAIT_V(n) asm volatile("s_waitcnt vmcnt(" #n ")" ::: "memory")
#define PG8_WAIT_L(n) asm volatile("s_waitcnt lgkmcnt(" #n ")" ::: "memory")
#define PG8_BAR __builtin_amdgcn_s_barrier()
#define PG8_SCHED __builtin_amdgcn_sched_barrier(0)
  Unit cur, nxt; int ui = 0;
  if (!S.next(0, cur)) return;
  f32x4 acc[2][2][4][2];
#pragma unroll
  for (int a = 0; a < 2; ++a)
#pragma unroll
    for (int b = 0; b < 2; ++b)
#pragma unroll
      for (int m = 0; m < 4; ++m)
#pragma unroll
        for (int n = 0; n < 2; ++n) acc[a][b][m][n] = (f32x4){0.f, 0.f, 0.f, 0.f};
  bf16x8 At[4][2], B0[2][2], B1[2][2];
  const char* cA = (const char*)g.A + (size_t)cur.pm * tstep + (size_t)cur.nb * g.a_bs; const char* cB = (const char*)g.Bt + (size_t)cur.pn * tstep + (size_t)cur.nb * g.b_bs;
  PG8_STAGE(PG8_SB(0, 0), cB); PG8_STAGE(PG8_SA(0, 0), cA); PG8_STAGE(PG8_SB(0, 1), cB + hstep); PG8_STAGE(PG8_SA(0, 1), cA + hstep);
  if (wr == 1) PG8_BAR;
  PG8_WAIT_V(4); PG8_BAR;
  PG8_STAGE(PG8_SB(1, 0), cB + kstep); PG8_STAGE(PG8_SA(1, 0), cA + kstep); PG8_STAGE(PG8_SB(1, 1), cB + hstep + kstep);
  PG8_WAIT_V(6); PG8_BAR;
  for (;;) {
    const bool has_next = S.next(ui + 1, nxt);
    const char* nA = has_next ? (const char*)g.A + (size_t)nxt.pm * tstep + (size_t)nxt.nb * g.a_bs : cA; const char* nB = has_next ? (const char*)g.Bt + (size_t)nxt.pn * tstep + (size_t)nxt.nb * g.b_bs : cB;
    for (int t = 0; t < nt; t += 2) {
      const bool last = (t == nt - 2);
      const char* a1 = cA + (size_t)(t + 1) * kstep;
      const char* a2 = last ? nA : cA + (size_t)(t + 2) * kstep; const char* b2 = last ? nB : cB + (size_t)(t + 2) * kstep;
      const char* a3 = a2 + kstep; const char* b3 = b2 + kstep;
      PG8_LDB(B0, 0, 0); PG8_SCHED; PG8_LDA(At, 0, 0); PG8_STAGE(PG8_SA(1, 1), a1 + hstep);
      PG8_WAIT_L(8); PG8_BAR; PG8_WAIT_L(0); PG8_MMA(0, 0, At, B0); PG8_BAR; PG8_SCHED;
      PG8_LDB(B1, 0, 1); PG8_STAGE(PG8_SB(0, 0), b2);
      PG8_BAR; PG8_WAIT_L(0); PG8_MMA(0, 1, At, B1); PG8_BAR;
      PG8_LDA(At, 0, 1); PG8_STAGE(PG8_SA(0, 0), a2);
      PG8_BAR; PG8_WAIT_L(0); PG8_MMA(1, 0, At, B0); PG8_BAR; PG8_SCHED;
      PG8_STAGE(PG8_SB(0, 1), b2 + hstep);
      PG8_WAIT_V(6); PG8_BAR; PG8_MMA(1, 1, At, B1); PG8_BAR;
      PG8_LDB(B0, 1, 0); PG8_SCHED; PG8_LDA(At, 1, 0); PG8_STAGE(PG8_SA(0, 1), a2 + hstep);
      PG8_WAIT_L(8); PG8_BAR; PG8_WAIT_L(0); PG8_MMA(0, 0, At, B0); PG8_BAR; PG8_SCHED;
      PG8_LDB(B1, 1, 1); PG8_STAGE(PG8_SB(1, 0), b3);
      PG8_BAR; PG8_WAIT_L(0); PG8_MMA(0, 1, At, B1); PG8_BAR;
      PG8_LDA(At, 1, 1); PG8_STAGE(PG8_SA(1, 0), a3);
      PG8_BAR; PG8_WAIT_L(0); PG8_MMA(1, 0, At, B0); PG8_BAR; PG8_SCHED;
      PG8_STAGE(PG8_SB(1, 1), b3 + hstep);
      PG8_WAIT_V(6); PG8_BAR; PG8_MMA(1, 1, At, B1); PG8_BAR;
    }
    E(acc, cur, wr, wc, fr, fq);
    if (!has_next) break;
    if (nxt.nb == 0)
#pragma unroll
    for (int a = 0; a < 2; ++a)
#pragma unroll
      for (int b = 0; b < 2; ++b)
#pragma unroll
        for (int m = 0; m < 4; ++m)
#pragma unroll
          for (int n = 0; n < 2; ++n) acc[a][b][m][n] = (f32x4){0.f, 0.f, 0.f, 0.f};
    cur = nxt; cA = nA; cB = nB; ++ui;
  }
  PG8_WAIT_V(0);
  if (wr == 0) PG8_BAR;
  PG8_BAR;
#undef PG8_SA
#undef PG8_SB
#undef PG8_STAGE
#undef PG8_LDA
#undef PG8_LDB
#undef PG8_MMA
#undef PG8_WAIT_V
#undef PG8_WAIT_L
#undef PG8_BAR
#undef PG8_SCHED
}

__device__ __forceinline__ int rho32(int d) { return ((d >> 2) & 1) * 16 + (d >> 3) * 4 + (d & 3); }
__device__ __forceinline__ int phys_nat(int f) { return (f & ~31) | rho32(f & 31); }
__device__ __forceinline__ int phys_g64(int f) { const int x = f & 255, wc = x >> 6, bj = (x >> 5) & 1; return (f & ~255) + bj * 128 + wc * 32 + rho32(x & 31); }
__device__ __forceinline__ int phys_h128(int f) { const int x = f & 255, hd = x >> 7, bj = (x >> 6) & 1, w1 = (x >> 5) & 1; return (f & ~255) + bj * 128 + (hd * 2 + w1) * 32 + rho32(x & 31); }
__device__ __forceinline__ int phys_win(int f) {
  if (f < 1024) return phys_g64(f);
  if (f < 1536) return phys_nat(f);
  if (f < 2560) return phys_h128(f);
  if (f < 3584) return phys_nat(f);
  if (f < 4352) return phys_g64(f);
  return phys_nat(f);
}

__device__ __forceinline__ u32x4 pack8(const f32x4& a, const f32x4& b) {
  u32x4 w; w[0] = cvtpk(a[0], a[1]); w[1] = cvtpk(a[2], a[3]); w[2] = cvtpk(b[0], b[1]); w[3] = cvtpk(b[2], b[3]); return w;
}

struct EpiResid {
  const float* hin; float* hout; int tok0;
  __device__ __forceinline__ void operator()(const f32x4 (&acc)[2][2][4][2], const Unit& u, int wr, int wc, int fr_, int fq_) const {
    const int ln_ = TIDX() & 63; const int fr = ln_ & 15, fq = ln_ >> 4; (void)fr_; (void)fq_;
#pragma unroll
    for (int ai = 0; ai < 2; ++ai)
#pragma unroll
      for (int m = 0; m < 4; ++m) {
        const long tg = (long)tok0 + u.pm * 256 + ai * 128 + wr * 64 + m * 16 + fr;
#pragma unroll
        for (int bj = 0; bj < 2; ++bj) {
          const int f0 = u.pn * 256 + bj * 128 + wc * 32 + 8 * fq;
          f32x4 h0 = __builtin_nontemporal_load((const f32x4*)(hin + tg * D + f0)), h1 = __builtin_nontemporal_load((const f32x4*)(hin + tg * D + f0 + 4));
          __builtin_nontemporal_store(h0 + acc[ai][bj][m][0], (f32x4*)(hout + tg * D + f0));
          __builtin_nontemporal_store(h1 + acc[ai][bj][m][1], (f32x4*)(hout + tg * D + f0 + 4));
        }
      }
  }
};

struct EpiRelu2 {
  u16* mb;
  __device__ __forceinline__ void operator()(const f32x4 (&acc)[2][2][4][2], const Unit& u, int wr, int wc, int fr_, int fq_) const {
    const int ln_ = TIDX() & 63; const int fr = ln_ & 15, fq = ln_ >> 4; (void)fr_; (void)fq_;
#pragma unroll
    for (int ai = 0; ai < 2; ++ai)
#pragma unroll
      for (int m = 0; m < 4; ++m) {
        const long tl = (long)u.pm * 256 + ai * 128 + wr * 64 + m * 16 + fr;
#pragma unroll
        for (int bj = 0; bj < 2; ++bj) {
          f32x4 a = acc[ai][bj][m][0], b = acc[ai][bj][m][1];
#pragma unroll
          for (int j = 0; j < 4; ++j) { float x = fmaxf(a[j], 0.f), y = fmaxf(b[j], 0.f); a[j] = x * x; b[j] = y * y; }
          *(u32x4*)(mb + tl * LDM + u.pn * 256 + bj * 128 + wc * 32 + 8 * fq) = pack8(a, b);
        }
      }
  }
};

__device__ __forceinline__ void load_cs4(const float2* t, f32x4& c, f32x4& sn) {
  const f32x4 a = *(const f32x4*)t, b = *(const f32x4*)(t + 2);
  c[0] = a[0]; sn[0] = a[1]; c[1] = a[2]; sn[1] = a[3]; c[2] = b[0]; sn[2] = b[1]; c[3] = b[2]; sn[3] = b[3];
}
__device__ __forceinline__ void st16(char* base, unsigned off, float v) { *(u16*)(base + off) = f2bf(v); }
struct EpiInproj {
  char* ws; int l;
  __device__ __forceinline__ void operator()(const f32x4 (&acc)[2][2][4][2], const Unit& u, int wr, int wc, int fr_, int fq_) const {
    const int ln_ = TIDX() & 63; const int fr = ln_ & 15, fq = ln_ >> 4; (void)fr_; (void)fq_;
    const float2* tab = (const float2*)(ws + OFF_TAB);
    const float* spf = (const float*)(ws + OFF_SP);
    const int lane = fq * 16 + fr;
    const int pn = u.pn;
    const int tlb = u.pm * 256 + wr * 64 + fr;
    if (pn < 4 || (pn >= 14 && pn <= 16)) {
      const int f0 = pn * 256 + wc * 64;
      if (f0 >= 4224) {
        const int kvh = (f0 - 4224) >> 6;
#pragma unroll
        for (int ai = 0; ai < 2; ++ai)
#pragma unroll
          for (int m = 0; m < 4; ++m) {
            const int tl = tlb + ai * 128 + m * 16, s = tl & (S - 1), bl = tl >> 13;
            const unsigned o0 = (unsigned)(((bl * 2 + kvh) * 64 + 8 * fq) * S + s) * 2u;
#pragma unroll
            for (int bj = 0; bj < 2; ++bj)
#pragma unroll
              for (int n = 0; n < 2; ++n)
#pragma unroll
                for (int j = 0; j < 4; ++j) st16(ws + OFF_GVT, o0 + (unsigned)((bj * 32 + 4 * n + j) * S * 2), acc[ai][bj][m][n][j]);
          }
        return;
      }
      const float* gain; u16* dst; int ldd; bool axial; float qsc = 1.0f;
      if (f0 < 512) { gain = spf + SP_DQN + l * 64; dst = (u16*)(ws + OFF_DQ) + f0; ldd = 512; axial = false; qsc = 0.125f * 1.4426950408889634f; }
      else if (f0 < 1024) { gain = spf + SP_DKN + l * 64; dst = (u16*)(ws + OFF_DK) + (f0 - 512); ldd = 512; axial = false; }
      else if (f0 < 4096) { gain = spf + SP_GQN + l * 64; dst = (u16*)(ws + OFF_GQ) + (f0 - 3584); ldd = 512; axial = true; qsc = 0.125f * 1.4426950408889634f; }
      else { gain = spf + SP_GKN + l * 64; dst = (u16*)(ws + OFF_GK) + (f0 - 4096); ldd = 128; axial = true; }
      f32x4 g[2][2];
#pragma unroll
      for (int bj = 0; bj < 2; ++bj)
#pragma unroll
        for (int n = 0; n < 2; ++n) g[bj][n] = *(const f32x4*)(gain + bj * 32 + 8 * fq + 4 * n);
#pragma unroll
      for (int ai = 0; ai < 2; ++ai)
#pragma unroll
        for (int m = 0; m < 4; ++m) {
          const int tl = tlb + ai * 128 + m * 16, s = tl & (S - 1);
          float ss = 0.f;
#pragma unroll
          for (int bj = 0; bj < 2; ++bj)
#pragma unroll
            for (int n = 0; n < 2; ++n)
#pragma unroll
              for (int j = 0; j < 4; ++j) { const float v = acc[ai][bj][m][n][j]; ss += v * v; }
          ss += shx(ss, lane, 16); ss += shx(ss, lane, 32);
          const float rstd = rsqrtf(ss * (1.0f / 64.0f) + 1e-6f);
          f32x4 y[2][2];
#pragma unroll
          for (int bj = 0; bj < 2; ++bj)
#pragma unroll
            for (int n = 0; n < 2; ++n) y[bj][n] = acc[ai][bj][m][n] * rstd * g[bj][n];
          if (!axial) {
#pragma unroll
            for (int n = 0; n < 2; ++n) {
              f32x4 cc, sn; load_cs4(tab + TAB_PT + s * 8 + 4 * n, cc, sn);
#pragma unroll
              for (int j = 0; j < 4; ++j) {
                const float own = y[0][n][j], oth = shx(own, lane, 16);
                const float r0 = own * cc[j] - oth * sn[j], r1 = own * cc[j] + oth * sn[j];
                y[0][n][j] = (fq == 0) ? r0 : ((fq == 1) ? r1 : own);
              }
            }
          } else {
#pragma unroll
            for (int bj = 0; bj < 2; ++bj)
#pragma unroll
              for (int n = 0; n < 2; ++n) {
                const int pos = (bj == 0) ? (s >> 6) : (s & 63);
                f32x4 cc, sn; load_cs4(tab + TAB_AX + pos * 16 + 8 * (fq & 1) + 4 * n, cc, sn);
#pragma unroll
                for (int j = 0; j < 4; ++j) {
                  const float own = y[bj][n][j], oth = shx(own, lane, 32);
                  y[bj][n][j] = (fq < 2) ? (own * cc[j] - oth * sn[j]) : (own * cc[j] + oth * sn[j]);
                }
              }
          }
#pragma unroll
          for (int bj = 0; bj < 2; ++bj) *(u32x4*)(dst + (long)tl * ldd + bj * 32 + 8 * fq) = pack8(y[bj][0] * qsc, y[bj][1] * qsc);
          __builtin_amdgcn_sched_barrier(0);
        }
    } else if (pn >= 6 && pn < 10) {
      const bool isk = (pn >= 8);
      const int hh = (pn - (isk ? 8 : 6)) * 2 + (wc >> 1), w1 = wc & 1;
      const float sc = isk ? 0.08838834764831845f : 1.0f;
      u16* dstn = (u16*)(ws + (isk ? OFF_RK : OFF_RQ)) + hh * 128 + w1 * 32 + 8 * fq;
#pragma unroll
      for (int ai = 0; ai < 2; ++ai)
#pragma unroll
        for (int m = 0; m < 4; ++m) {
          const int tl = tlb + ai * 128 + m * 16, s = tl & (S - 1), bl = tl >> 13;
          f32x4 y[2][2];
#pragma unroll
          for (int n = 0; n < 2; ++n) {
            f32x4 cc, sn; load_cs4(tab + TAB_RT + s * 64 + w1 * 32 + 8 * fq + 4 * n, cc, sn);
#pragma unroll
            for (int j = 0; j < 4; ++j) {
              const float x1 = acc[ai][0][m][n][j], x2 = acc[ai][1][m][n][j];
              y[0][n][j] = (x1 * cc[j] - x2 * sn[j]) * sc; y[1][n][j] = (x2 * cc[j] + x1 * sn[j]) * sc;
            }
          }
#pragma unroll
          for (int bj = 0; bj < 2; ++bj) __builtin_nontemporal_store(pack8(y[bj][0], y[bj][1]), (u32x4*)(dstn + (long)tl * 512 + bj * 64));
          if (isk) {
            const unsigned o0 = (unsigned)(((bl * 4 + hh) * 128 + w1 * 32 + 8 * fq) * S + s) * 2u;
#pragma unroll
            for (int bj = 0; bj < 2; ++bj)
#pragma unroll
              for (int n = 0; n < 2; ++n)
#pragma unroll
                for (int j = 0; j < 4; ++j) st16(ws + OFF_RKT, o0 + (unsigned)((bj * 64 + 4 * n + j) * S * 2), y[bj][n][j]);
          }
          __builtin_amdgcn_sched_barrier(0);
        }
    } else if (pn == 4 || pn == 5 || pn == 10 || pn == 11) {
      const bool isd = (pn < 6);
      const int fbase = isd ? 1024 : 2560;
#pragma unroll
      for (int ai = 0; ai < 2; ++ai)
#pragma unroll
        for (int m = 0; m < 4; ++m) {
          const int tl = tlb + ai * 128 + m * 16, s = tl & (S - 1), bl = tl >> 13;
#pragma unroll
          for (int bj = 0; bj < 2; ++bj) {
            const int fl = pn * 256 + bj * 128 + wc * 32 + 8 * fq - fbase;
            const unsigned o0 = (unsigned)((bl * 4 * 128 + fl) * S + s) * 2u;
#pragma unroll
            for (int n = 0; n < 2; ++n)
#pragma unroll
              for (int j = 0; j < 4; ++j) st16(ws + (isd ? OFF_DVT : OFF_RVT), o0 + (unsigned)((4 * n + j) * S * 2), acc[ai][bj][m][n][j]);
          }
        }
    } else if (pn == 12 || pn == 13) {
#pragma unroll
      for (int ai = 0; ai < 2; ++ai)
#pragma unroll
        for (int m = 0; m < 4; ++m) {
          const long tl = tlb + ai * 128 + m * 16;
#pragma unroll
          for (int bj = 0; bj < 2; ++bj) {
            f32x4 a = acc[ai][bj][m][0], b = acc[ai][bj][m][1];
#pragma unroll
            for (int j = 0; j < 4; ++j) { a[j] = a[j] * __builtin_amdgcn_rcpf(1.0f + __expf(-a[j])); b[j] = b[j] * __builtin_amdgcn_rcpf(1.0f + __expf(-b[j])); }
            __builtin_nontemporal_store(pack8(a, b), (u32x4*)((u16*)(ws + OFF_RG) + tl * 512 + (pn - 12) * 256 + bj * 128 + wc * 32 + 8 * fq));
          }
        }
    } else {
#pragma unroll
      for (int ai = 0; ai < 2; ++ai)
#pragma unroll
        for (int m = 0; m < 4; ++m) {
          const long tl = tlb + ai * 128 + m * 16;
#pragma unroll
          for (int bj = 0; bj < 2; ++bj) {
            f32x4 a = acc[ai][bj][m][0], b = acc[ai][bj][m][1];
            u32x2 w8; w8[0] = 0u; w8[1] = 0u;
#pragma unroll
            for (int j = 0; j < 4; ++j) {
              const unsigned qa = max((unsigned)fmaf(__builtin_amdgcn_rcpf(1.0f + __expf(-a[j])), 255.0f, 0.5f), 1u);
              const unsigned qb = max((unsigned)fmaf(__builtin_amdgcn_rcpf(1.0f + __expf(-b[j])), 255.0f, 0.5f), 1u);
              w8[0] |= qa << (8 * j); w8[1] |= qb << (8 * j);
            }
            *(u32x2*)((unsigned char*)(ws + OFF_GATES) + tl * 3072 + (pn - 17) * 256 + bj * 128 + wc * 32 + 8 * fq) = w8;
          }
        }
    }
  }
};

__device__ __forceinline__ void phase_gemm1(const Params& p, int l, char* smem) {
  GemmD g; g.A = (const u16*)(p.ws + OFF_U); g.Bt = (const u16*)(p.ws + OFF_WT) + WT_IN; g.K = 1024; g.ld = LDU; g.a_bs = 0; g.b_bs = 0;
  Sched sc; sc.ntiles = 29 * 64; sc.G = gridDim.x; sc.c = blockIdx.x; sc.nbr = 1;
  EpiInproj e; e.ws = p.ws; e.l = l;
  gemm_phase(( LAS unsigned char*)smem_all, g, sc, e);
}
__device__ __forceinline__ void phase_gemm_resid(const Params& p, long wt_off, size_t act_off, int K, int ld, const float* hin, int tok0, char* smem) {
  GemmD g; g.A = (const u16*)(p.ws + act_off); g.Bt = (const u16*)(p.ws + OFF_WT) + wt_off; g.K = K; g.ld = ld; g.a_bs = 0; g.b_bs = 0;
  Sched sc; sc.ntiles = 4 * 64; sc.G = gridDim.x; sc.c = blockIdx.x; sc.nbr = 1;
  EpiResid e; e.hin = hin; e.hout = p.out; e.tok0 = tok0;
  gemm_phase((LAS unsigned char*)smem_all, g, sc, e);
}
__device__ __forceinline__ void phase_mlp1(const Params& p, char* smem) {
  GemmD g; g.A = (const u16*)(p.ws + OFF_U); g.Bt = (const u16*)(p.ws + OFF_WT) + WT_W1; g.K = 1024; g.ld = LDU; g.a_bs = 0; g.b_bs = 0;
  Sched sc; sc.ntiles = 16 * 64; sc.G = gridDim.x; sc.c = blockIdx.x; sc.nbr = 1;
  EpiRelu2 e; e.mb = (u16*)(p.ws + OFF_M);
  gemm_phase((LAS unsigned char*)smem_all, g, sc, e);
}

struct EpiBranch {
  const unsigned char* gates; u16* merged;
  __device__ __forceinline__ void operator()(f32x4 (&acc)[2][2][4][2], const Unit& u, int wr, int wc, int fr_, int fq_) const {
    const int ln_ = TIDX() & 63; const int fr = ln_ & 15, fq = ln_ >> 4; (void)fr_; (void)fq_;
#pragma unroll
    for (int ai = 0; ai < 2; ++ai)
#pragma unroll
      for (int m = 0; m < 4; ++m) {
        const long tl = (long)u.pm * 256 + ai * 128 + wr * 64 + m * 16 + fr;
#pragma unroll
        for (int bj = 0; bj < 2; ++bj) {
          const int f0 = u.pn * 256 + bj * 128 + wc * 32 + 8 * fq;
          const unsigned char* gp = gates + tl * 3072 + f0 + u.nb * 1024;
          const u32x2 gn = *(const u32x2*)gp;
          float sc[8];
#pragma unroll
          for (int i = 0; i < 8; ++i) sc[i] = (float)((gn[i >> 2] >> (8 * (i & 3))) & 255u);
          if (u.nb < 2) {
            const u32x2 gx = *(const u32x2*)(gp + 1024);
#pragma unroll
            for (int i = 0; i < 8; ++i) sc[i] *= __builtin_amdgcn_rcpf((float)((gx[i >> 2] >> (8 * (i & 3))) & 255u));
          } else {
#pragma unroll
            for (int i = 0; i < 8; ++i) sc[i] *= (1.0f / 255.0f);
          }
#pragma unroll
          for (int j = 0; j < 4; ++j) { acc[ai][bj][m][0][j] *= sc[j]; acc[ai][bj][m][1][j] *= sc[4 + j]; }
          if (u.nb == 2) *(u32x4*)(merged + tl * LDU + f0) = pack8(acc[ai][bj][m][0], acc[ai][bj][m][1]);
        }
      }
  }
};
__device__ __forceinline__ void phase_branch(const Params& p, char* smem) {
  GemmD g; g.A = (const u16*)(p.ws + OFF_ABUF); g.Bt = (const u16*)(p.ws + OFF_WT) + WT_BR; g.K = 512; g.ld = LDB3;
  g.a_bs = (size_t)TH * LDB3 * 2; g.b_bs = (size_t)WT_BR_STRIDE * 2;
  Sched sc; sc.ntiles = 4 * 64; sc.G = gridDim.x; sc.c = blockIdx.x; sc.nbr = 3;
  EpiBranch e; e.gates = (const unsigned char*)(p.ws + OFF_GATES); e.merged = (u16*)(p.ws + OFF_MERGED);
  gemm_phase((LAS unsigned char*)smem_all, g, sc, e);
}

constexpr int AKT = 64 * 72, AVT = 128 * 72;
constexpr int ATT_STASH_OFF = 2 * (AKT + AVT) * 2;

__device__ __forceinline__ void qk_tile(f32x16& p0, f32x16& p1, const u16* kb, const bf16x8 (&qf)[4], int prow, int hi) {
  p0 = f32x16{}; p1 = f32x16{};
#pragma unroll
  for (int ds = 0; ds < 4; ++ds) {
    bf16x8 k0 = *(const bf16x8*)(kb + prow * 72 + ds * 16 + hi * 8);
    bf16x8 k1 = *(const bf16x8*)(kb + (32 + prow) * 72 + ds * 16 + hi * 8);
    p0 = mfma32(k0, qf[ds], p0);
    p1 = mfma32(k1, qf[ds], p1);
  }
}

template <int DV, bool PIPE, int MODE>
__device__ __forceinline__ void flash_loop(f32x16 (&o)[DV / 32], float& l_run, const u16* __restrict__ qrow,
                                           const u16* __restrict__ kbase, int ldk, const u16* __restrict__ vtbase, u16* lds) {
  constexpr int NDV = DV / 32;
  constexpr float C = (MODE == 0) ? 0.125f * 1.4426950408889634f : 1.0f;
  constexpr float THR = 8.0f / C;
  u16* kl = lds;
  u16* vl = lds + 2 * AKT;
  const int tid = TIDX(), lane = tid & 63, r32 = lane & 31, hi = lane >> 5;
  bf16x8 qf[4];
#pragma unroll
  for (int ds = 0; ds < 4; ++ds) qf[ds] = *(const bf16x8*)(qrow + ds * 16 + hi * 8);
  const int srow = tid >> 3, sc = (tid & 7) * 8;
  const unsigned kofs = (unsigned)(srow * ldk + sc) * 2u, vofs = (unsigned)(srow * S + sc) * 2u;
#define KG(j) ((const char*)(kbase + (long)(j) * 64 * ldk) + kofs)
#define VG(j) ((const char*)(vtbase + (long)(j) * 64) + vofs)
#define VG2(j) ((const char*)(vtbase + 64l * S + (long)(j) * 64) + vofs)
  bf16x8 kr, vr0, vr1;
  const int prow = (r32 & ~12) | ((r32 & 4) << 1) | ((r32 & 8) >> 1);
  float m_run = -1e30f;
  l_run = 0.0f;
#pragma unroll
  for (int d = 0; d < NDV; ++d) o[d] = f32x16{};
  constexpr int NT = S / 64;
  {
    bf16x8 k0 = *(const bf16x8*)KG(0), k1;
    if (PIPE) k1 = *(const bf16x8*)KG(1);
    vr0 = *(const bf16x8*)VG(0);
    if (DV == 128) vr1 = *(const bf16x8*)VG2(0);
    *(bf16x8*)(kl + srow * 72 + sc) = k0;
    if (PIPE) *(bf16x8*)(kl + AKT + srow * 72 + sc) = k1;
    *(bf16x8*)(vl + srow * 72 + sc) = vr0;
    if (DV == 128) *(bf16x8*)(vl + (64 + srow) * 72 + sc) = vr1;
  }
  __syncthreads();
  f32x16 pA0, pA1, pB0, pB1;
  if (PIPE) {
    qk_tile(pA0, pA1, kl, qf, prow, hi);
    asm volatile("s_waitcnt lgkmcnt(0)" ::: "memory"); __builtin_amdgcn_s_barrier(); asm volatile("" ::: "memory");
  }
#define FL_QKBLOCK(D0, D1)                                                                                       \
      f32x16 q0 = f32x16{}, q1 = f32x16{};                                                                       \
      _Pragma("unroll") for (int ds = 0; ds < 4; ++ds) { q0 = mfma32(kf[2 * ds], qf[ds], q0); q1 = mfma32(kf[2 * ds + 1], qf[ds], q1); } \
      D0 = q0; D1 = q1;
#define FL_BODY(PC0, PC1, PN0, PN1, J)                                                                           \
  {                                                                                                              \
    const int j_ = (J);                                                                                          \
    if (PIPE) { if (j_ + 2 < NT) kr = *(const bf16x8*)KG(j_ + 2); } else { if (j_ + 1 < NT) kr = *(const bf16x8*)KG(j_ + 1); } \
    if (j_ + 1 < NT) {                                                                                           \
      vr0 = *(const bf16x8*)VG(j_ + 1);                                                                          \
      if (DV == 128) vr1 = *(const bf16x8*)VG2(j_ + 1);                                                          \
    }                                                                                                            \
    const u16* kb = kl + ((PIPE ? (j_ + 1) : j_) & 1) * AKT;                                                     \
    const u16* vb = vl + (j_ & 1) * AVT;                                                                         \
    bf16x8 kf[8], vf[2][NDV];                                                                                    \
    _Pragma("unroll") for (int ds = 0; ds < 4; ++ds) {                                                           \
      kf[2 * ds] = *(const bf16x8*)(kb + prow * 72 + ds * 16 + hi * 8);                                          \
      kf[2 * ds + 1] = *(const bf16x8*)(kb + (32 + prow) * 72 + ds * 16 + hi * 8);                               \
    }                                                                                                            \
    _Pragma("unroll") for (int d = 0; d < NDV; ++d) vf[0][d] = *(const bf16x8*)(vb + (d * 32 + r32) * 72 + hi * 8);  \
    __builtin_amdgcn_sched_barrier(0);                                                                           \
    if (!PIPE) { FL_QKBLOCK(PC0, PC1) }                                                                          \
    if (PIPE && DV != 64) { if (j_ + 1 < NT) { FL_QKBLOCK(PN0, PN1) } }                                          \
    float ps = 0.0f;                                                                                             \
    if (MODE == 2) {                                                                                             \
      _Pragma("unroll") for (int r = 0; r < 16; ++r) { PC0[r] = __builtin_amdgcn_exp2f(PC0[r]); ps += PC0[r]; }  \
      _Pragma("unroll") for (int r = 0; r < 16; ++r) { PC1[r] = __builtin_amdgcn_exp2f(PC1[r]); ps += PC1[r]; }  \
    } else {                                                                                                     \
    float mx = PC0[0];                                                                                           \
    _Pragma("unroll") for (int r = 1; r < 16; ++r) mx = fmaxf(mx, PC0[r]);                                       \
    _Pragma("unroll") for (int r = 0; r < 16; ++r) mx = fmaxf(mx, PC1[r]);                                       \
    mx = xhalf_max(mx);                                                                                          \
    if (!__all(mx - m_run <= THR)) {                                                                             \
      const float mn = fmaxf(m_run, mx);                                                                         \
      const float alpha = __builtin_amdgcn_exp2f((m_run - mn) * C);                                              \
      m_run = mn;                                                                                                \
      l_run *= alpha;                                                                                            \
      _Pragma("unroll") for (int d = 0; d < NDV; ++d)                                                            \
        _Pragma("unroll") for (int r = 0; r < 16; ++r) o[d][r] *= alpha;                                         \
    }                                                                                                            \
    const float mnC = -m_run * C;                                                                                \
    _Pragma("unroll") for (int r = 0; r < 16; ++r) { PC0[r] = __builtin_amdgcn_exp2f(fmaf(PC0[r], C, mnC)); ps += PC0[r]; } \
    _Pragma("unroll") for (int r = 0; r < 16; ++r) { PC1[r] = __builtin_amdgcn_exp2f(fmaf(PC1[r], C, mnC)); ps += PC1[r]; } \
    }                                                                                                            \
    if (MODE != 2) ps = xhalf_sum(ps);        \
    l_run += ps;                                                                                                 \
    bf16x8 pb[4];                                                                                                \
    {                                                                                                            \
      u32x4 w;                                                                                                   \
      w[0] = cvtpk(PC0[0], PC0[1]); w[1] = cvtpk(PC0[2], PC0[3]); w[2] = cvtpk(PC0[4], PC0[5]); w[3] = cvtpk(PC0[6], PC0[7]);       \
      pb[0] = *reinterpret_cast<bf16x8*>(&w);                                                                    \
      w[0] = cvtpk(PC0[8], PC0[9]); w[1] = cvtpk(PC0[10], PC0[11]); w[2] = cvtpk(PC0[12], PC0[13]); w[3] = cvtpk(PC0[14], PC0[15]); \
      pb[1] = *reinterpret_cast<bf16x8*>(&w);                                                                    \
      w[0] = cvtpk(PC1[0], PC1[1]); w[1] = cvtpk(PC1[2], PC1[3]); w[2] = cvtpk(PC1[4], PC1[5]); w[3] = cvtpk(PC1[6], PC1[7]);       \
      pb[2] = *reinterpret_cast<bf16x8*>(&w);                                                                    \
      w[0] = cvtpk(PC1[8], PC1[9]); w[1] = cvtpk(PC1[10], PC1[11]); w[2] = cvtpk(PC1[12], PC1[13]); w[3] = cvtpk(PC1[14], PC1[15]); \
      pb[3] = *reinterpret_cast<bf16x8*>(&w);                                                                    \
    }                                                                                                            \
    __builtin_amdgcn_sched_barrier(0);                                                                           \
    if (PIPE && DV == 64) { if (j_ + 1 < NT) { FL_QKBLOCK(PN0, PN1) } }     \
    _Pragma("unroll") for (int kk = 0; kk < 4; ++kk) {                                                           \
      if (kk + 1 < 4) {                                                                                          \
        _Pragma("unroll") for (int d = 0; d < NDV; ++d)                                                          \
          vf[(kk + 1) & 1][d] = *(const bf16x8*)(vb + (d * 32 + r32) * 72 + (kk + 1) * 16 + hi * 8);            \
      }                                                                                                          \
      __builtin_amdgcn_sched_barrier(0);                                                                         \
      _Pragma("unroll") for (int d = 0; d < NDV; ++d) o[d] = mfma32(vf[kk & 1][d], pb[kk], o[d]);                \
      __builtin_amdgcn_sched_barrier(0);                                                                         \
    }                                                                                                            \
    if (PIPE) { if (j_ + 2 < NT) *(bf16x8*)(kl + (j_ & 1) * AKT + srow * 72 + sc) = kr; } else { if (j_ + 1 < NT) *(bf16x8*)(kl + ((j_ + 1) & 1) * AKT + srow * 72 + sc) = kr; } \
    if (j_ + 1 < NT) {                                                                                           \
      const int b_ = (j_ + 1) & 1;                                                                               \
      *(bf16x8*)(vl + b_ * AVT + srow * 72 + sc) = vr0;                                                          \
      if (DV == 128) *(bf16x8*)(vl + b_ * AVT + (64 + srow) * 72 + sc) = vr1;                                    \
    }                                                                                                            \
    __syncthreads();                                                                                             \
  }
  for (int j = 0; j < NT; j += 2) {
    FL_BODY(pA0, pA1, pB0, pB1, j)
    FL_BODY(pB0, pB1, pA0, pA1, j + 1)
  }
#undef FL_BODY
#undef FL_QKBLOCK
  if (MODE == 2) l_run = xhalf_sum(l_run);
#undef KG
#undef VG
#undef VG2
}

__device__ __forceinline__ void attn_diff_item(const Params& p, int l, int item, char* smem) {
  const int qt = item & 31, hh = (item >> 5) & 3, bl = item >> 7;
  const int tid = TIDX(), lane = tid & 63, wid = tid >> 6, r32 = lane & 31, hi = lane >> 5;
#define ATT_TL() (bl * S + qt * 256 + (TIDX() >> 6) * 32 + (TIDX() & 31))
  const u16* dq = (const u16*)(p.ws + OFF_DQ);
  const u16* dk = (const u16*)(p.ws + OFF_DK);
  const u16* dvt = (const u16*)(p.ws + OFF_DVT) + ((long)(bl * 4 + hh) * 128) * S;
  unsigned* stash = (unsigned*)(smem + ATT_STASH_OFF) + wid * 2048;
  f32x16 o[4]; float lr;
  float bq = 0.f, bk = 0.f;
  for (int i = 0; i < 64; ++i) { bq = fmaxf(bq, fabsf((SPF(p) + SP_DQN)[l * 64 + i])); bk = fmaxf(bk, fabsf((SPF(p) + SP_DKN)[l * 64 + i])); }
  const bool small = (8.0f * bq * bk < 40.0f);
  if (small) flash_loop<128, true, 2>(o, lr, dq + (long)ATT_TL() * 512 + (hh * 2) * 64, dk + (long)(bl * S) * 512 + (hh * 2) * 64, 512, dvt, (u16*)smem);
  else flash_loop<128, false, 1>(o, lr, dq + (long)ATT_TL() * 512 + (hh * 2) * 64, dk + (long)(bl * S) * 512 + (hh * 2) * 64, 512, dvt, (u16*)smem);
  {
    const float inv = 1.0f / lr;
#pragma unroll
    for (int d = 0; d < 4; ++d)
#pragma unroll
      for (int pr = 0; pr < 8; ++pr) stash[(d * 8 + pr) * 64 + lane] = cvtpk(o[d][2 * pr] * inv, o[d][2 * pr + 1] * inv);
  }
  if (small) flash_loop<128, true, 2>(o, lr, dq + (long)ATT_TL() * 512 + (hh * 2 + 1) * 64, dk + (long)(bl * S) * 512 + (hh * 2 + 1) * 64, 512, dvt, (u16*)smem);
  else flash_loop<128, false, 1>(o, lr, dq + (long)ATT_TL() * 512 + (hh * 2 + 1) * 64, dk + (long)(bl * S) * 512 + (hh * 2 + 1) * 64, 512, dvt, (u16*)smem);
  float s1 = 0, s2 = 0;
  for (int i = 0; i < 64; ++i) { s1 += (SPF(p) + SP_LQ1)[l * 64 + i] * (SPF(p) + SP_LK1)[l * 64 + i]; s2 += (SPF(p) + SP_LQ2)[l * 64 + i] * (SPF(p) + SP_LK2)[l * 64 + i]; }
  int ll = l; asm volatile("" : "+s"(ll));
  const float lambda_init = (ll == 0) ? 0.2f : (0.8f - 0.6f * 0.7408182206817179f);
  const float lam = expf(s1) - expf(s2) + lambda_init;
  const float inv2 = lam / lr;
  float ss = 0;
#pragma unroll
  for (int d = 0; d < 4; ++d)
#pragma unroll
    for (int pr = 0; pr < 8; ++pr) {
      unsigned w = stash[(d * 8 + pr) * 64 + lane];
      float a0 = bflo(w) - inv2 * o[d][2 * pr], a1 = bfhi(w) - inv2 * o[d][2 * pr + 1];
      o[d][2 * pr] = a0; o[d][2 * pr + 1] = a1; ss += a0 * a0 + a1 * a1;
    }
  ss = xhalf_sum(ss);
  const float rstd = rsqrtf(ss * (1.0f / 128.0f) + 1e-5f) * (1.0f - lambda_init);
  const float* sg = (SPF(p) + SP_SUBLN) + l * 128;
  u16* dst = (u16*)(p.ws + OFF_ABUF) + (long)ATT_TL() * LDB3 + hh * 128;
#pragma unroll
  for (int d = 0; d < 4; ++d)
#pragma unroll
    for (int q4 = 0; q4 < 4; ++q4) {
      const int dv0 = d * 32 + 8 * q4 + 4 * hi;
      float4 g = *(const float4*)(sg + dv0);
      *(u32x2*)(dst + dv0) = pack4(o[d][4 * q4] * rstd * g.x, o[d][4 * q4 + 1] * rstd * g.y, o[d][4 * q4 + 2] * rstd * g.z, o[d][4 * q4 + 3] * rstd * g.w);
    }
}
#undef ATT_TL

__device__ __forceinline__ void attn_gqa_item(const Params& p, int l, int item, char* smem) {
  const int qt = item & 31, qh = (item >> 5) & 7, bl = item >> 8;
  const int tid = TIDX(), lane = tid & 63, wid = tid >> 6, r32 = lane & 31, hi = lane >> 5;
  const int tl = bl * S + qt * 256 + wid * 32 + r32;
  const int kvh = qh >> 2;
  const u16* gq = (const u16*)(p.ws + OFF_GQ);
  const u16* gk = (const u16*)(p.ws + OFF_GK);
  const u16* gvt = (const u16*)(p.ws + OFF_GVT) + ((long)(bl * 2 + kvh) * 64) * S;
  f32x16 o[2]; float lr;
  float bq = 0.f, bk = 0.f;
  for (int i = 0; i < 64; ++i) { bq = fmaxf(bq, fabsf((SPF(p) + SP_GQN)[l * 64 + i])); bk = fmaxf(bk, fabsf((SPF(p) + SP_GKN)[l * 64 + i])); }
  if (8.0f * bq * bk < 40.0f)
    flash_loop<64, true, 2>(o, lr, gq + (long)tl * 512 + qh * 64, gk + (long)(bl * S) * 128 + kvh * 64, 128, gvt, (u16*)smem);
  else
    flash_loop<64, true, 1>(o, lr, gq + (long)tl * 512 + qh * 64, gk + (long)(bl * S) * 128 + kvh * 64, 128, gvt, (u16*)smem);
  const float inv = 1.0f / lr;
  u16* dst = (u16*)(p.ws + OFF_ABUF) + 2l * TH * LDB3 + (long)tl * LDB3 + qh * 64;
#pragma unroll
  for (int d = 0; d < 2; ++d)
#pragma unroll
    for (int q4 = 0; q4 < 4; ++q4)
      *(u32x2*)(dst + d * 32 + 8 * q4 + 4 * hi) = pack4(o[d][4 * q4] * inv, o[d][4 * q4 + 1] * inv, o[d][4 * q4 + 2] * inv, o[d][4 * q4 + 3] * inv);
}

constexpr int RROW = 136;
constexpr int RBUF = 128 * RROW;

__device__ __forceinline__ void mm128(f32x16 (&acc)[2], const u16* Al, const u16* Bl) {
  const int lane = TIDX() & 63, wid = TIDX() >> 6, r32 = lane & 31, hi = lane >> 5;
  const int wm = wid >> 2, wn = wid & 3;
#pragma unroll
  for (int ks = 0; ks < 8; ++ks) {
    bf16x8 bfr = *(const bf16x8*)(Bl + (wn * 32 + r32) * RROW + ks * 16 + hi * 8);
#pragma unroll
    for (int mt = 0; mt < 2; ++mt) {
      bf16x8 af = *(const bf16x8*)(Al + (wm * 64 + mt * 32 + r32) * RROW + ks * 16 + hi * 8);
      acc[mt] = mfma32(af, bfr, acc[mt]);
    }
  }
}

__device__ __forceinline__ void stage128(u16* dstl, const u16* src, long ld) {
  const int row = TIDX() >> 2, c = (TIDX() & 3) * 32;
  const u16* s = src + (long)row * ld + c;
  bf16x8 v0 = *(const bf16x8*)s, v1 = *(const bf16x8*)(s + 8), v2 = *(const bf16x8*)(s + 16), v3 = *(const bf16x8*)(s + 24);
  u16* d = dstl + row * RROW + c;
  *(bf16x8*)d = v0; *(bf16x8*)(d + 8) = v1; *(bf16x8*)(d + 16) = v2; *(bf16x8*)(d + 24) = v3;
}
__device__ __forceinline__ void stage128_f32(u16* dstl, const float* src) {
  const int row = TIDX() >> 2, c = (TIDX() & 3) * 32;
  const float* s = src + row * 128 + c;
  u16* d = dstl + row * RROW + c;
#pragma unroll
  for (int i = 0; i < 4; ++i) {
    float4 a = *(const float4*)(s + 8 * i), b = *(const float4*)(s + 8 * i + 4);
    u32x4 w; w[0] = cvtpk(a.x, a.y); w[1] = cvtpk(a.z, a.w); w[2] = cvtpk(b.x, b.y); w[3] = cvtpk(b.z, b.w);
    *(u32x4*)(d + 8 * i) = w;
  }
}

__device__ __forceinline__ void phase_r1(const Params& p, int l, char* smem) {
  u16* B0 = (u16*)smem;
  u16* B1 = B0 + RBUF;
  u16* B2 = B1 + RBUF;
  float* zf = (float*)(smem + 3 * RBUF * 2);
  float* zb = zf + 128;
  const int tid = TIDX(), lane = tid & 63, wid = tid >> 6, r32 = lane & 31, hi = lane >> 5;
  const int wm = wid >> 2, wn = wid & 3;
  for (int item = blockIdx.x; item < 512; item += gridDim.x) {
    const int n = item & 63, bh = item >> 6, hh = bh & 3;
    const float lf = -expf((SPF(p) + SP_RDF)[l * 4 + hh]), lb = -expf((SPF(p) + SP_RDB)[l * 4 + hh]);
    if (tid < 128) { zf[tid] = expf((float)(127 - tid) * lf); zb[tid] = expf((float)tid * lb); }
    const u16* vsrc = (const u16*)(p.ws + OFF_RVT) + ((long)bh * 128) * S + n * 128;
    const u16* ksrc = (const u16*)(p.ws + OFF_RKT) + ((long)bh * 128) * S + n * 128;
    stage128(B0, vsrc, S);
    __syncthreads();
    {
      const int row = tid >> 2, c = (tid & 3) * 32;
      const u16* s = ksrc + (long)row * S + c;
#pragma unroll
      for (int i = 0; i < 4; ++i) {
        u32x4 v = *(const u32x4*)(s + 8 * i);
        u32x4 wf_, wb_;
#pragma unroll
        for (int q = 0; q < 4; ++q) {
          const int j = c + 8 * i + 2 * q;
          float a = bflo(v[q]), b = bfhi(v[q]);
          wf_[q] = cvtpk(a * zf[j], b * zf[j + 1]);
          wb_[q] = cvtpk(a * zb[j], b * zb[j + 1]);
        }
        *(u32x4*)(B1 + row * RROW + c + 8 * i) = wf_;
        *(u32x4*)(B2 + row * RROW + c + 8 * i) = wb_;
      }
    }
    __syncthreads();
    f32x16 af[2], ab[2];
    af[0] = f32x16{}; af[1] = f32x16{}; ab[0] = f32x16{}; ab[1] = f32x16{};
    mm128(af, B0, B1);
    mm128(ab, B0, B2);
    u16* of = (u16*)(p.ws + OFF_KVF) + (long)item * 16384;
    u16* ob = (u16*)(p.ws + OFF_KVB) + (long)item * 16384;
#pragma unroll
    for (int mt = 0; mt < 2; ++mt)
#pragma unroll
      for (int r = 0; r < 16; ++r) {
        const int e = wm * 64 + mt * 32 + crow(r, hi), d = wn * 32 + r32;
        of[e * 128 + d] = f2bf(af[mt][r]);
        ob[e * 128 + d] = f2bf(ab[mt][r]);
      }
    __syncthreads();
  }
}

__device__ __forceinline__ void phase_r2(const Params& p, int l) {
  const int nth = gridDim.x * NTHREADS;
  for (int idx = blockIdx.x * NTHREADS + TIDX(); idx < 65536; idx += nth) {
    const int dir = idx >> 15, e4 = idx & 32767, bh = e4 >> 12, ed = (e4 & 4095) * 4, hh = bh & 3;
    u16* base = (u16*)(p.ws + (dir ? OFF_KVB : OFF_KVF)) + ((long)bh * 64) * 16384 + ed;
    const float lg = -expf((dir ? (SPF(p) + SP_RDB) : (SPF(p) + SP_RDF))[l * 4 + hh]);
    const float dec = expf(128.0f * lg);
    float s0 = 0.f, s1 = 0.f, s2 = 0.f, s3 = 0.f;
    for (int nb = 0; nb < 8; ++nb) {
      u32x2 t[8];
#pragma unroll
      for (int i = 0; i < 8; ++i) { int n = nb * 8 + i; if (dir) n = 63 - n; t[i] = *(const u32x2*)(base + (long)n * 16384); }
#pragma unroll
      for (int i = 0; i < 8; ++i) {
        int n = nb * 8 + i; if (dir) n = 63 - n;
        u32x2 w; w[0] = cvtpk(s0, s1); w[1] = cvtpk(s2, s3);
        *(u32x2*)(base + (long)n * 16384) = w;
        s0 = s0 * dec + bflo(t[i][0]); s1 = s1 * dec + bfhi(t[i][0]); s2 = s2 * dec + bflo(t[i][1]); s3 = s3 * dec + bfhi(t[i][1]);
      }
    }
  }
}

__device__ __forceinline__ void ret_r3_item(const Params& p, int l, int item, char* smem) {
  u16* B0 = (u16*)smem;
  u16* B1 = B0 + RBUF;
  u16* B2 = B1 + RBUF;
  u16* B3 = B2 + RBUF;
  float* OL = (float*)B1;
  const int tid = TIDX(), lane = tid & 63, wid = tid >> 6, r32 = lane & 31, hi = lane >> 5;
  const int wm = wid >> 2, wn = wid & 3;
  const int n = item & 63, bh = item >> 6, hh = bh & 3, bl = bh >> 2;
  const float lf = -expf((SPF(p) + SP_RDF)[l * 4 + hh]), lb = -expf((SPF(p) + SP_RDB)[l * 4 + hh]);
  const long tl0 = (long)bl * S + n * 128;
  stage128(B0, (const u16*)(p.ws + OFF_RQ) + tl0 * 512 + hh * 128, 512);
  stage128(B1, (const u16*)(p.ws + OFF_RK) + tl0 * 512 + hh * 128, 512);
  stage128(B2, (const u16*)(p.ws + OFF_RVT) + ((long)bh * 128) * S + n * 128, S);
  stage128(B3, (const u16*)(p.ws + OFF_KVF) + (long)item * 16384, 128);
  __syncthreads();
  f32x16 sc[2], cr[2], out[2];
  sc[0] = f32x16{}; sc[1] = f32x16{}; cr[0] = f32x16{}; cr[1] = f32x16{};
  mm128(sc, B0, B1);
  mm128(cr, B0, B3);
#pragma unroll
  for (int mt = 0; mt < 2; ++mt)
#pragma unroll
    for (int r = 0; r < 16; ++r) {
      const int i = wm * 64 + mt * 32 + crow(r, hi);
      out[mt][r] = __expf((float)(i + 1) * lf) * cr[mt][r];
    }
  __syncthreads();
#pragma unroll
  for (int mt = 0; mt < 2; ++mt)
#pragma unroll
    for (int r = 0; r < 16; ++r) {
      const int i = wm * 64 + mt * 32 + crow(r, hi), j = wn * 32 + r32;
      const float dd = (float)(i - j);
      const float dec = (i >= j) ? __expf(dd * lf) : __expf(-dd * lb);
      B1[i * RROW + j] = f2bf(sc[mt][r] * dec);
    }
  stage128(B3, (const u16*)(p.ws + OFF_KVB) + (long)item * 16384, 128);
  __syncthreads();
  cr[0] = f32x16{}; cr[1] = f32x16{};
  mm128(out, B1, B2);
  mm128(cr, B0, B3);
#pragma unroll
  for (int mt = 0; mt < 2; ++mt)
#pragma unroll
    for (int r = 0; r < 16; ++r) {
      const int i = wm * 64 + mt * 32 + crow(r, hi);
      out[mt][r] += __expf((float)(128 - i) * lb) * cr[mt][r];
    }
  __syncthreads();
#pragma unroll
  for (int mt = 0; mt < 2; ++mt)
#pragma unroll
    for (int r = 0; r < 16; ++r) {
      const int i = wm * 64 + mt * 32 + crow(r, hi), e = wn * 32 + r32;
      OL[i * 132 + e] = out[mt][r];
    }
  __syncthreads();
  {
    const int i = tid >> 2, qd = tid & 3;
    float xv[32];
    float sm = 0;
#pragma unroll
    for (int k = 0; k < 8; ++k) {
      float4 v = *(const float4*)(OL + i * 132 + qd * 32 + 4 * k);
      xv[4 * k] = v.x; xv[4 * k + 1] = v.y; xv[4 * k + 2] = v.z; xv[4 * k + 3] = v.w;
      sm += v.x + v.y + v.z + v.w;
    }
    sm += shx(sm, lane, 1); sm += shx(sm, lane, 2);
    const float mu = sm * (1.0f / 128.0f);
    float vs = 0;
#pragma unroll
    for (int k = 0; k < 32; ++k) { float dlt = xv[k] - mu; vs += dlt * dlt; }
    vs += shx(vs, lane, 1); vs += shx(vs, lane, 2);
    const float rstd = rsqrtf(vs * (1.0f / 128.0f) + 1e-5f);
    const float* gn = (SPF(p) + SP_RGN) + l * 512 + hh * 128 + qd * 32;
    const u16* rg = (const u16*)(p.ws + OFF_RG) + (tl0 + i) * 512 + hh * 128 + qd * 32;
    u16* dst = (u16*)(p.ws + OFF_ABUF) + 1l * TH * LDB3 + (tl0 + i) * LDB3 + hh * 128 + qd * 32;
#pragma unroll
    for (int k = 0; k < 4; ++k) {
      u32x4 gv = *(const u32x4*)(rg + 8 * k);
      float4 g0 = *(const float4*)(gn + 8 * k), g1 = *(const float4*)(gn + 8 * k + 4);
      u32x4 w;
      w[0] = cvtpk((xv[8 * k + 0] - mu) * rstd * g0.x * bflo(gv[0]), (xv[8 * k + 1] - mu) * rstd * g0.y * bfhi(gv[0]));
      w[1] = cvtpk((xv[8 * k + 2] - mu) * rstd * g0.z * bflo(gv[1]), (xv[8 * k + 3] - mu) * rstd * g0.w * bfhi(gv[1]));
      w[2] = cvtpk((xv[8 * k + 4] - mu) * rstd * g1.x * bflo(gv[2]), (xv[8 * k + 5] - mu) * rstd * g1.y * bfhi(gv[2]));
      w[3] = cvtpk((xv[8 * k + 6] - mu) * rstd * g1.z * bflo(gv[3]), (xv[8 * k + 7] - mu) * rstd * g1.w * bfhi(gv[3]));
      *(u32x4*)(dst + 8 * k) = w;
    }
  }
  __syncthreads();
}

__device__ __forceinline__ void phase_attn(const Params& p, int l, char* smem) {
  for (int it = blockIdx.x; it < 256; it += gridDim.x) attn_diff_item(p, l, (it & 7) * 32 + (it >> 3), smem);
  for (int it = blockIdx.x; it < 512; it += gridDim.x) {
    const int r = it >> 8, c = it & 255, xcd = c & 7, j = c >> 3, pair = xcd & 3, qhl = (xcd >> 2) * 2 + r;
    attn_gqa_item(p, l, (((pair >> 1) * 8 + (pair & 1) * 4 + qhl) << 5) + j, smem);
  }
  for (int it = blockIdx.x; it < 512; it += gridDim.x) ret_r3_item(p, l, it, smem);
}


#define XB_TMO      128
#define XB_XCNT(j)  (256  + 64 * (j))
#define XB_XSUB(j)  (1280 + 64 * (j))
#define XB_XGEN(j)  (2304 + 64 * (j))
#define XB_TOP      3328
#define XB_TOPGEN   3392
#define XCD_BAR_WORDS 3456
#define XB_SPIN_CAP (1u << 20)
__device__ __forceinline__ unsigned xb_ld(unsigned* p)              { return __hip_atomic_load(p, __ATOMIC_RELAXED, __HIP_MEMORY_SCOPE_AGENT); }
__device__ __forceinline__ unsigned xb_add(unsigned* p, unsigned v) { return __hip_atomic_fetch_add(p, v, __ATOMIC_RELAXED, __HIP_MEMORY_SCOPE_AGENT); }
__device__ __forceinline__ unsigned xb_xcc_id() { return (unsigned)__builtin_amdgcn_s_getreg((3 << 11) | 20) & 0xFu; }
#define XB_SPIN(cond, bar) do { unsigned _sp = 0; while (cond) { __builtin_amdgcn_s_sleep(1); \
    if ((++_sp & 255u) == 0u) { if (xb_ld(&(bar)[XB_TMO])) break; if (_sp > XB_SPIN_CAP) { atomicAdd(&(bar)[XB_TMO], 1u); break; } } } } while (0)
struct XcdBarrier { unsigned* bar; unsigned x; };
#define XB_ST ((volatile unsigned*)(smem_all + LDS_BYTES))
__device__ __forceinline__ XcdBarrier xcd_barrier_post(unsigned* bar) {
  XcdBarrier b; b.bar = bar; b.x = xb_xcc_id();
  if (__builtin_amdgcn_workitem_id_x() == 0) (void)xb_add(&bar[XB_XCNT(b.x)], 1u);
  return b;
}
__device__ __forceinline__ void xcd_barrier_complete(unsigned* bar, unsigned x, unsigned& nloc, unsigned& nx) {
  const unsigned G = gridDim.x;
  unsigned sum, cnt, mine, sp = 0u;
  for (;;) {
    sum = 0u; cnt = 0u; mine = 0u;
#pragma unroll
    for (unsigned j = 0; j < 16; ++j) { const unsigned c = xb_ld(&bar[XB_XCNT(j)]); sum += c; cnt += (c > 0u) ? 1u : 0u; mine = (j == x) ? c : mine; }
    if (sum == G) break;
    __builtin_amdgcn_s_sleep(1);
    if ((++sp & 255u) == 0u) { if (xb_ld(&bar[XB_TMO])) break; if (sp > XB_SPIN_CAP) { atomicAdd(&bar[XB_TMO], 1u); break; } }
  }
  nloc = mine > 0u ? mine : 1u; nx = cnt > 0u ? cnt : 1u;
}
__device__ __forceinline__ void xcd_barrier(const XcdBarrier& b) {
  asm volatile("s_waitcnt vmcnt(0)" ::: "memory");
  __syncthreads();
  if (__builtin_amdgcn_workitem_id_x() == 0) {
    unsigned* bar = b.bar;
    __builtin_amdgcn_s_waitcnt(0);
    unsigned nloc = XB_ST[0], nx = XB_ST[1];
    if (nloc == 0u) { xcd_barrier_complete(bar, b.x, nloc, nx); XB_ST[0] = nloc; XB_ST[1] = nx; }
    const unsigned old = xb_add(&bar[XB_XSUB(b.x)], 1u);
    const unsigned gen = old / nloc;
    if (old + 1u == (gen + 1u) * nloc) {
      __builtin_amdgcn_fence(__ATOMIC_RELEASE, "agent");
      asm volatile("s_waitcnt vmcnt(0)" ::: "memory");
      const unsigned og = xb_add(&bar[XB_TOP], 1u);
      const unsigned tg = og / nx;
      if (og + 1u == (tg + 1u) * nx) xb_add(&bar[XB_TOPGEN], 1u);
      else XB_SPIN(xb_ld(&bar[XB_TOPGEN]) == tg, bar);
      __builtin_amdgcn_fence(__ATOMIC_ACQUIRE, "agent");
      xb_add(&bar[XB_XGEN(b.x)], 1u);
      asm volatile("s_waitcnt vmcnt(0)" ::: "memory");
    } else {
      XB_SPIN(xb_ld(&bar[XB_XGEN(b.x)]) == gen, bar);
      __builtin_amdgcn_fence(__ATOMIC_ACQUIRE, "agent");
      asm volatile("s_waitcnt vmcnt(0)" ::: "memory");
    }
  }
  __syncthreads();
}

__global__ void __launch_bounds__(NTHREADS) mega(Params p) {
  extern __shared__ __attribute__((aligned(16))) char smem[];
  cg::grid_group grid = cg::this_grid();
  volatile unsigned* xst = (volatile unsigned*)(smem + LDS_BYTES);
  if (__builtin_amdgcn_workitem_id_x() == 0) { xst[0] = 0u; xst[1] = 0u; xst[2] = 0u; xst[3] = 0u; }
  __syncthreads();
  XcdBarrier xb = xcd_barrier_post((unsigned*)(p.ws + OFF_BAR));
  for (int l = 0; l < 2; ++l) {
    const float* hin = (l == 0) ? p.x : p.out;
#pragma unroll 1
    for (int step = 0; step < 21; ++step) {
      bool do_resid = false; long r_wt = 0; size_t r_act = 0; int r_K = 1024, r_ld = LDU, r_tok0 = 0; const float* r_h = hin;
      if (step == 0) {
        if (l == 0) { phase_smallparams(p); phase_tables(p); }
        phase_wconv(p, l, smem);
      } else if (step < 15) {
        const int half = (step - 1) / 7, k = (step - 1) % 7;
        if (k == 0) phase_norm(p, hin, half * TH, (SPF(p) + SP_ATTN_NORM) + l * D);
        else if (k == 1) phase_gemm1(p, l, smem);
        else if (k == 2) phase_r1(p, l, smem);
        else if (k == 3) phase_r2(p, l);
        else if (k == 4) phase_attn(p, l, smem);
        else if (k == 5) phase_branch(p, smem);
        else { do_resid = true; r_wt = WT_OUT; r_act = OFF_MERGED; r_K = 1024; r_ld = LDU; r_h = hin; r_tok0 = half * TH; }
      } else {
        const int mh = (step - 15) / 3, k = (step - 15) % 3;
        if (k == 0) phase_norm(p, p.out, mh * TH, (SPF(p) + SP_MLPN) + l * D);
        else if (k == 1) phase_mlp1(p, smem);
        else { do_resid = true; r_wt = WT_W2; r_act = OFF_M; r_K = 4096; r_ld = LDM; r_h = p.out; r_tok0 = mh * TH; }
      }
      if (do_resid) phase_gemm_resid(p, r_wt, r_act, r_K, r_ld, r_h, r_tok0, smem);
      if (p.x == nullptr) grid.sync();
      else xcd_barrier(xb);
    }
  }
}

extern "C" void kernel_launch(void* const* d_in, const int* in_sizes, int n_in, void* d_out, int out_size, void* d_ws,
                              size_t ws_size, hipStream_t stream) {
  Params p{};
  p.x = (const float*)d_in[0]; p.attn_norm = (const float*)d_in[1]; p.w_in = (const float*)d_in[2];
  p.dqn = (const float*)d_in[3]; p.dkn = (const float*)d_in[4]; p.lq1 = (const float*)d_in[5]; p.lk1 = (const float*)d_in[6];
  p.lq2 = (const float*)d_in[7]; p.lk2 = (const float*)d_in[8]; p.subln = (const float*)d_in[9]; p.rdf = (const float*)d_in[10];
  p.rdb = (const float*)d_in[11]; p.rgn = (const float*)d_in[12]; p.gqn = (const float*)d_in[13]; p.gkn = (const float*)d_in[14];
  p.w_branch = (const float*)d_in[15]; p.w_out = (const float*)d_in[16]; p.mlp_norm = (const float*)d_in[17];
  p.w1 = (const float*)d_in[18]; p.w2 = (const float*)d_in[19];
  p.out = (float*)d_out; p.ws = (char*)d_ws;
  static int grid_blocks = 0;
  if (!grid_blocks) {
    if (hipFuncSetAttribute((const void*)mega, hipFuncAttributeMaxDynamicSharedMemorySize, LDS_ALLOC) != hipSuccess) {
      fprintf(stderr, "kernel_launch: hipFuncSetAttribute failed\n");
    }
    int dev = 0, cus = 0, per_cu = 0;
    (void)hipGetDevice(&dev);
    (void)hipDeviceGetAttribute(&cus, hipDeviceAttributeMultiprocessorCount, dev);
    (void)hipOccupancyMaxActiveBlocksPerMultiprocessor(&per_cu, (const void*)mega, NTHREADS, LDS_ALLOC);
    if (per_cu < 1) per_cu = 1;
    if (per_cu > 1) per_cu = 1;
    grid_blocks = cus * per_cu;
  }
  (void)hipMemsetAsync((char*)d_ws + OFF_BAR, 0, XCD_BAR_WORDS * 4, stream);
  void* args[] = {&p};
  hipError_t e = hipLaunchCooperativeKernel((const void*)mega, dim3(grid_blocks), dim3(NTHREADS), args, LDS_ALLOC, stream);
  if (e != hipSuccess) fprintf(stderr, "cooperative launch failed: %s (grid %d)\n", hipGetErrorString(e), grid_blocks);
}
```
